# Optimizing an MI355X kernel written in HIP

```python
import jax, jax.numpy as jnp
from jax import lax
import numpy as np

D_MODEL = 1024
BATCH = 8
SEQ = 2048
DEPTH = 1

GLA_HEADS = 4
GLA_DK = D_MODEL // 8
GLA_DV = D_MODEL // 4
GLA_RANK = 16
GLA_NORMALIZER = 16.0
GLA_CHUNK = 64
MOBA_HEADS = 8
MOBA_DH = D_MODEL // 8
MOBA_BLOCK = 256
MOBA_TOPK = 3
MOBA_QCHUNK = 16
ROT_DIM = MOBA_DH // 4
ROPE_THETA = 500000.0
N_EXPERTS = 256
TOPK_EXPERTS = 8
N_GROUPS = 8
TOPK_GROUPS = 4
D_EXPERT = D_MODEL // 4
D_SHARED = D_MODEL // 4
ROUTED_SCALE = 2.5
DISPATCH_BLOCK = 128
PLE_DIM = 256
LN_EPS = 1e-5
ALPHA = (2.0 * DEPTH) ** 0.25
BETA = (8.0 * DEPTH) ** -0.25
GLA_KDIM = GLA_HEADS * GLA_DK
GLA_VDIM = GLA_HEADS * GLA_DV
MOBA_DIM = MOBA_HEADS * MOBA_DH
IN_COLS = 2 * GLA_KDIM + 2 * GLA_VDIM + GLA_RANK + 3 * MOBA_DIM + 2 * D_MODEL

kernel_name = 'hybrid_gla_moba_moe_deepnorm'

F32 = jnp.float32


def layer_norm(x, g, b):
    xf = x.astype(F32)
    mu = xf.mean(-1, keepdims=True)
    var = jnp.square(xf - mu).mean(-1, keepdims=True)
    return ((xf - mu) * lax.rsqrt(var + LN_EPS) * g.astype(F32) + b.astype(F32)).astype(x.dtype)


def split_in(proj):
    sizes = (GLA_KDIM, GLA_KDIM, GLA_VDIM, GLA_VDIM, GLA_RANK,
             MOBA_DIM, MOBA_DIM, MOBA_DIM, D_MODEL, D_MODEL)
    offs = [int(o) for o in np.cumsum(sizes)[:-1]]
    return jnp.split(proj, offs, axis=-1)


def rope_partial(x, positions):
    inv = ROPE_THETA ** (-jnp.arange(0, ROT_DIM, 2, dtype=F32) / ROT_DIM)
    ang = positions.astype(F32)[..., None] * inv
    cos = jnp.cos(ang)[:, :, None, :]
    sin = jnp.sin(ang)[:, :, None, :]
    xr = x[..., :ROT_DIM].astype(F32)
    x1, x2 = xr[..., :ROT_DIM // 2], xr[..., ROT_DIM // 2:]
    rot = jnp.concatenate([x1 * cos - x2 * sin, x1 * sin + x2 * cos], axis=-1)
    return jnp.concatenate([rot.astype(x.dtype), x[..., ROT_DIM:]], axis=-1)


def gla_mixer(q, k, v, r, lowrank, w_gk2, b_gk, norm_g):
    B, T, _ = q.shape
    dt = q.dtype
    nc = T // GLA_CHUNK
    gk = jax.nn.log_sigmoid((lowrank @ w_gk2 + b_gk).astype(F32)) / GLA_NORMALIZER

    def heads(t, d):
        return t.astype(F32).reshape(B, nc, GLA_CHUNK, GLA_HEADS, d).transpose(0, 3, 1, 2, 4)

    qh = heads(q, GLA_DK) * (GLA_DK ** -0.5)
    kh = heads(k, GLA_DK)
    vh = heads(v, GLA_DV)
    gh = heads(gk, GLA_DK)
    b = jnp.cumsum(gh, axis=3)
    b_end = b[:, :, :, -1:, :]
    q_e = qh * jnp.exp(b)
    k_e = kh * jnp.exp(-b)
    k_d = kh * jnp.exp(b_end - b)
    causal = jnp.tril(jnp.ones((GLA_CHUNK, GLA_CHUNK), bool))
    att = jnp.where(causal, jnp.einsum('bhncd,bhnsd->bhncs', q_e, k_e), 0.0)
    o_intra = jnp.einsum('bhncs,bhnse->bhnce', att, vh)
    upd = jnp.einsum('bhncd,bhnce->bhnde', k_d, vh)
    decay = jnp.exp(b_end[:, :, :, 0, :])

    def step(state, inp):
        dcy, u = inp
        return dcy[..., None] * state + u, state

    s0 = jnp.zeros((B, GLA_HEADS, GLA_DK, GLA_DV), F32)
    _, s_prev = lax.scan(step, s0, (jnp.moveaxis(decay, 2, 0), jnp.moveaxis(upd, 2, 0)))
    s_prev = jnp.moveaxis(s_prev, 0, 2)
    o = o_intra + jnp.einsum('bhncd,bhnde->bhnce', q_e, s_prev)
    o = o.transpose(0, 2, 3, 1, 4).reshape(B, T, GLA_HEADS, GLA_DV)
    o = o * lax.rsqrt(jnp.square(o).mean(-1, keepdims=True) + LN_EPS) * norm_g.astype(F32)
    o = o.reshape(B, T, GLA_VDIM) * jax.nn.silu(r.astype(F32))
    return o.astype(dt)


def moba_mixer(q, k, v, positions):
    B, T, _ = q.shape
    dt = q.dtype
    H, DH, BLK, QC = MOBA_HEADS, MOBA_DH, MOBA_BLOCK, MOBA_QCHUNK
    qh = rope_partial(q.reshape(B, T, H, DH), positions)
    kh = rope_partial(k.reshape(B, T, H, DH), positions)
    vh = v.reshape(B, T, H, DH)
    nb = -(-T // BLK)
    tp = nb * BLK
    K = min(MOBA_TOPK, nb)
    nq = tp // QC
    pad = ((0, 0), (0, tp - T), (0, 0), (0, 0))
    qh, kh, vh = [jnp.pad(t, pad).transpose(0, 2, 1, 3) for t in (qh, kh, vh)]
    k_blocks = kh.reshape(B, H, nb, BLK, DH)
    v_blocks = vh.reshape(B, H, nb, BLK, DH)
    k_mean = k_blocks.astype(F32).mean(axis=3)
    s_blk = jnp.einsum('bhtd,bhnd->bhtn', qh.astype(F32), k_mean)
    q_blk = jnp.arange(tp) // BLK
    past = jnp.arange(nb)[None, :] < q_blk[:, None]
    s_blk = jnp.where(past, s_blk, -jnp.inf)
    _, sel = lax.top_k(s_blk, K)
    q_chunks = qh.reshape(B, H, nq, QC, DH).transpose(2, 0, 1, 3, 4)
    sel_chunks = sel.reshape(B, H, nq, QC, K).transpose(2, 0, 1, 3, 4)
    bi = jnp.arange(B)[:, None, None, None]
    hi = jnp.arange(H)[None, :, None, None]
    scale = DH ** -0.5

    def chunk_attn(args):
        c, q_c, sel_c = args
        start = c * QC
        qb = start // BLK
        k_sel = k_blocks[bi, hi, sel_c]
        v_sel = v_blocks[bi, hi, sel_c]
        s_sel = jnp.einsum('bhqd,bhqkjd->bhqkj', q_c, k_sel).astype(F32) * scale
        valid = (jnp.arange(K) < qb)[:, None]
        s_sel = jnp.where(valid, s_sel, -jnp.inf).reshape(B, H, QC, K * BLK)
        k_own = lax.dynamic_index_in_dim(k_blocks, qb, axis=2, keepdims=False)
        v_own = lax.dynamic_index_in_dim(v_blocks, qb, axis=2, keepdims=False)
        s_own = jnp.einsum('bhqd,bhjd->bhqj', q_c, k_own).astype(F32) * scale
        causal = jnp.arange(BLK)[None, :] <= (start - qb * BLK + jnp.arange(QC))[:, None]
        s_own = jnp.where(causal, s_own, -jnp.inf)
        probs = jax.nn.softmax(jnp.concatenate([s_sel, s_own], axis=-1), axis=-1).astype(dt)
        p_sel = probs[..., :K * BLK].reshape(B, H, QC, K, BLK)
        p_own = probs[..., K * BLK:]
        return (jnp.einsum('bhqkj,bhqkjd->bhqd', p_sel, v_sel)
                + jnp.einsum('bhqj,bhjd->bhqd', p_own, v_own))

    out = lax.map(chunk_attn, (jnp.arange(nq), q_chunks, sel_chunks))
    out = out.transpose(1, 0, 3, 2, 4).reshape(B, tp, H * DH)[:, :T]
    return out.astype(dt)


def moe_ffn(x, w_router, b_router, w_e_gate, w_e_up, w_e_down, w_s_gate, w_s_up, w_s_down):
    B, T, D = x.shape
    n = B * T
    nk = n * TOPK_EXPERTS
    xf = x.reshape(n, D)
    scores = jax.nn.sigmoid((xf @ w_router).astype(F32))
    biased = scores + b_router.astype(F32)
    g_score = lax.top_k(biased.reshape(n, N_GROUPS, N_EXPERTS // N_GROUPS), 2)[0].sum(-1)
    _, g_idx = lax.top_k(g_score, TOPK_GROUPS)
    g_mask = jnp.any(g_idx[:, :, None] == jnp.arange(N_GROUPS)[None, None, :], axis=1)
    e_mask = jnp.repeat(g_mask, N_EXPERTS // N_GROUPS, axis=1)
    _, e_idx = lax.top_k(jnp.where(e_mask, biased, -jnp.inf), TOPK_EXPERTS)
    w_sel = jnp.take_along_axis(scores, e_idx, axis=1)
    w_sel = w_sel / w_sel.sum(-1, keepdims=True) * ROUTED_SCALE
    flat_e = e_idx.reshape(-1)
    flat_tok = jnp.repeat(jnp.arange(n, dtype=jnp.int32), TOPK_EXPERTS)
    flat_w = w_sel.reshape(-1)
    order = jnp.argsort(flat_e)
    s_e, s_tok, s_w = flat_e[order], flat_tok[order], flat_w[order]
    counts = jnp.bincount(flat_e, length=N_EXPERTS)
    starts = jnp.cumsum(counts) - counts
    pcounts = (counts + DISPATCH_BLOCK - 1) // DISPATCH_BLOCK * DISPATCH_BLOCK
    pends = jnp.cumsum(pcounts)
    pstarts = pends - pcounts
    dest = pstarts[s_e] + (jnp.arange(nk) - starts[s_e])
    n_blk = (nk + N_EXPERTS * (DISPATCH_BLOCK - 1) + DISPATCH_BLOCK - 1) // DISPATCH_BLOCK
    rows = n_blk * DISPATCH_BLOCK
    row_tok = jnp.full((rows,), n, jnp.int32).at[dest].set(s_tok)
    row_w = jnp.zeros((rows,), F32).at[dest].set(s_w)
    blk_e = jnp.clip(jnp.searchsorted(pends, jnp.arange(n_blk) * DISPATCH_BLOCK, side='right'),
                     0, N_EXPERTS - 1)
    x_pad = jnp.concatenate([xf, jnp.zeros((1, D), xf.dtype)], axis=0)

    def expert_block(args):
        tok, wr, e = args
        xb = x_pad[tok]
        h = jax.nn.silu(xb @ w_e_gate[e]) * (xb @ w_e_up[e])
        return (h @ w_e_down[e]) * wr[:, None].astype(xb.dtype)

    ys = lax.map(expert_block, (row_tok.reshape(n_blk, DISPATCH_BLOCK),
                                row_w.reshape(n_blk, DISPATCH_BLOCK), blk_e))
    routed = jax.ops.segment_sum(ys.reshape(rows, D), row_tok, num_segments=n + 1)[:n]
    shared = (jax.nn.silu(xf @ w_s_gate) * (xf @ w_s_up)) @ w_s_down
    return (routed + shared).reshape(B, T, D)


def setup_inputs(seed: int = 0) -> dict:
    key = jax.random.key(seed)
    ks = jax.random.split(key, 24)

    def nrm(k, shape, scale):
        return jax.random.normal(k, shape, F32) * scale

    L, D, E = DEPTH, D_MODEL, N_EXPERTS
    return {
        'x': nrm(ks[0], (BATCH, SEQ, D), 1.0),
        'p': nrm(ks[1], (DEPTH, BATCH, SEQ, PLE_DIM), 1.0),
        'positions': jnp.broadcast_to(jnp.arange(SEQ, dtype=jnp.int32), (BATCH, SEQ)),
        'w_in': nrm(ks[2], (L, D, IN_COLS), D ** -0.5),
        'w_gla_gk2': nrm(ks[3], (L, GLA_RANK, GLA_KDIM), GLA_RANK ** -0.5),
        'b_gla_gk': nrm(ks[4], (L, GLA_KDIM), 0.1),
        'gla_norm_g': 1.0 + nrm(ks[5], (L, GLA_DV), 0.02),
        'w_gla_o': nrm(ks[6], (L, GLA_VDIM, D), GLA_VDIM ** -0.5 * BETA),
        'w_moba_o': nrm(ks[7], (L, MOBA_DIM, D), MOBA_DIM ** -0.5 * BETA),
        'w_out': nrm(ks[8], (L, D, D), D ** -0.5 * BETA),
        'ln1_g': 1.0 + nrm(ks[9], (L, D), 0.02),
        'ln1_b': nrm(ks[10], (L, D), 0.02),
        'w_router': nrm(ks[11], (L, D, E), D ** -0.5),
        'b_router': nrm(ks[12], (L, E), 0.01),
        'w_e_gate': nrm(ks[13], (L, E, D, D_EXPERT), D ** -0.5),
        'w_e_up': nrm(ks[14], (L, E, D, D_EXPERT), D ** -0.5),
        'w_e_down': nrm(ks[15], (L, E, D_EXPERT, D), D_EXPERT ** -0.5 * BETA),
        'w_s_gate': nrm(ks[16], (L, D, D_SHARED), D ** -0.5),
        'w_s_up': nrm(ks[17], (L, D, D_SHARED), D ** -0.5),
        'w_s_down': nrm(ks[18], (L, D_SHARED, D), D_SHARED ** -0.5 * BETA),
        'w_ple': nrm(ks[19], (L, PLE_DIM, D), PLE_DIM ** -0.5 * BETA),
        'w_ple_gate': nrm(ks[20], (L, D, D), D ** -0.5),
        'ln2_g': 1.0 + nrm(ks[21], (L, D), 0.02),
        'ln2_b': nrm(ks[22], (L, D), 0.02),
    }


def reference(x, p, positions, w_in, w_gla_gk2, b_gla_gk, gla_norm_g, w_gla_o, w_moba_o,
              w_out, ln1_g, ln1_b, w_router, b_router, w_e_gate, w_e_up, w_e_down,
              w_s_gate, w_s_up, w_s_down, w_ple, w_ple_gate, ln2_g, ln2_b):
    h = x
    for i in range(DEPTH):
        proj = h @ w_in[i]
        (g_q, g_k, g_v, g_r, g_low, m_q, m_k, m_v, gate_a, gate_b) = split_in(proj)
        y_gla = gla_mixer(g_q, g_k, g_v, g_r, g_low, w_gla_gk2[i], b_gla_gk[i], gla_norm_g[i]) @ w_gla_o[i]
        y_moba = moba_mixer(m_q, m_k, m_v, positions) @ w_moba_o[i]
        merged = jax.nn.sigmoid(gate_a) * y_gla + jax.nn.sigmoid(gate_b) * y_moba
        mix = merged @ w_out[i]
        h1 = layer_norm(ALPHA * h + mix, ln1_g[i], ln1_b[i])
        ffn = moe_ffn(h1, w_router[i], b_router[i], w_e_gate[i], w_e_up[i], w_e_down[i],
                      w_s_gate[i], w_s_up[i], w_s_down[i])
        ple = jax.nn.sigmoid(h1 @ w_ple_gate[i]) * (p[i] @ w_ple[i])
        h = layer_norm(ALPHA * h1 + ffn + ple, ln2_g[i], ln2_b[i])
    return h
```

```cpp
#include <hip/hip_runtime.h>
#include <cstdio>
#include <cstdint>
#include <cmath>
#ifndef MK_N_LAUNCHES
#define MK_N_LAUNCHES 1
#endif
constexpr int NWAVES = 8;
constexpr int BATCH = 8, SEQ = 2048, DM = 1024, M = BATCH * SEQ;
constexpr int GLA_H = 4, GLA_DK = 128, GLA_DV = 256, GLA_RANK = 16, GLA_CHUNK = 64;
constexpr int MOBA_H = 8, MOBA_DH = 128, MOBA_BLK = 256, MOBA_NB = SEQ / MOBA_BLK;
constexpr int NEXP = 256, TOPK = 8, NGRP = 8, TOPKG = 4, DEXP = 256, PLE_DIM = 256;
constexpr int IN_COLS = 8208, NPROJ = 8448;
constexpr int PP = 8192;
constexpr int C_GQ = 0, C_GK = 512, C_GV = 1024, C_GR = 2048, C_MQ = 3072, C_MK = 4096, C_MV = 5120, C_GA = 6144, C_GB = 7168;
constexpr float LN_EPS = 1e-5f;
constexpr float ALPHA = 1.189207115002721f;
constexpr float ROUTED_SCALE = 2.5f;

constexpr size_t MiB = 1u << 20;
constexpr size_t WS_CTL = 0, CTL_ZERO_BYTES = 1 * MiB;
constexpr size_t WS_CS = 1 * MiB;
constexpr size_t WS_LOW = 3 * MiB;
constexpr size_t WS_KMEAN = 4 * MiB;
constexpr size_t WS_TOPE = 5 * MiB;
constexpr size_t WS_TOPP = 5 * MiB + 512 * 1024;
constexpr size_t WS_WR = 8 * MiB, WS_WP = 8 * MiB + 512 * 1024, WS_WS1 = 9 * MiB, WS_WS2 = 10 * MiB;
constexpr size_t WS_WGO = 12 * MiB, WS_WMO = 14 * MiB, WS_WOUT = 16 * MiB, WS_WPG = 18 * MiB;
constexpr size_t WS_WIN = 20 * MiB;
constexpr size_t WS_LIST = 38 * MiB;
constexpr size_t WS_WLIST = 54 * MiB;
constexpr size_t WS_LOGITS = 70 * MiB;
constexpr size_t WS_XB = 86 * MiB;
constexpr size_t WS_PB = 118 * MiB;
constexpr size_t WS_PW = 126 * MiB;
constexpr size_t WS_H1B = 158 * MiB;
constexpr size_t WS_WE1 = 190 * MiB;
constexpr size_t WS_WE2 = 446 * MiB;
constexpr size_t WS_R1 = 574 * MiB;
constexpr size_t WS_PROJ = WS_R1, WS_PRE1 = WS_R1, WS_YS = WS_R1;
constexpr size_t WS_R2 = 832 * MiB;
constexpr size_t WS_OG = WS_R2, WS_A1 = WS_R2 + 32 * MiB, WS_OM = WS_R2 + 64 * MiB, WS_MERGED = WS_R2 + 96 * MiB;
constexpr size_t WS_HEXP = WS_R2, WS_YSH = WS_R2 + 66 * MiB, WS_HSH = WS_R2 + 98 * MiB, WS_PLE = WS_R2 + 106 * MiB;
constexpr size_t WS_END = WS_R2 + 138 * MiB;
static_assert(WS_YS + (size_t)(M * TOPK + 256) * DM * 2 <= WS_R2, "YS fits R1");
static_assert(WS_END <= 1024 * MiB, "ws budget");
constexpr int CW_COUNTS = 1024;
constexpr int CW_DBG = 2048;
constexpr int CW_BAR = 4096;

constexpr int RING_OFF = 0, RING_BYTES = 131072;
constexpr int LDSCTL_OFF = RING_BYTES, MISC_OFF = LDSCTL_OFF + 320;
constexpr int TAB_OFF = RING_BYTES + 1024;
constexpr int LDS_BYTES = 147456;

#define GAS __attribute__((address_space(1)))
#define LAS __attribute__((address_space(3)))
typedef unsigned short bf16;
typedef unsigned v4u __attribute__((ext_vector_type(4)));
typedef unsigned v2u __attribute__((ext_vector_type(2)));
typedef float f32x4 __attribute__((ext_vector_type(4)));
typedef short bf16x8 __attribute__((ext_vector_type(8)));
typedef GAS unsigned gu32;
#define RLX_AGENT __ATOMIC_RELAXED, __HIP_MEMORY_SCOPE_AGENT
#define LDS_WAIT() asm volatile("s_waitcnt lgkmcnt(0)" ::: "memory")
#define VM_WAIT() asm volatile("s_waitcnt vmcnt(0)" ::: "memory")
__device__ __forceinline__ unsigned f2bf(float f) { unsigned u = __builtin_bit_cast(unsigned, f); return (u + 0x7fffu + ((u >> 16) & 1u)) >> 16; }
__device__ __forceinline__ unsigned pk2(float lo, float hi) { return f2bf(lo) | (f2bf(hi) << 16); }
__device__ __forceinline__ float bf2f(unsigned short h) { return __uint_as_float(((unsigned)h) << 16); }

#define XB_TMO      128
#define XB_XCNT(j)  (256  + 64 * (j))
#define XB_XSUB(j)  (1280 + 64 * (j))
#define XB_XGEN(j)  (2304 + 64 * (j))
#define XB_TOP      3328
#define XB_TOPGEN   3392
#define XCD_BAR_WORDS 3456
#define XB_SPIN_CAP (1u << 18)
__device__ __forceinline__ unsigned xb_ld(unsigned* p)              { return __hip_atomic_load(p, __ATOMIC_RELAXED, __HIP_MEMORY_SCOPE_AGENT); }
__device__ __forceinline__ unsigned xb_add(unsigned* p, unsigned v) { return __hip_atomic_fetch_add(p, v, __ATOMIC_RELAXED, __HIP_MEMORY_SCOPE_AGENT); }
__device__ __forceinline__ unsigned xb_xcc_id() { return (unsigned)__builtin_amdgcn_s_getreg((3 << 11) | 20) & 0xFu; }
#define XB_SPIN(cond, bar) do { unsigned _sp = 0; while (cond) { __builtin_amdgcn_s_sleep(1); \
    if ((++_sp & 255u) == 0u) { if (xb_ld(&(bar)[XB_TMO])) break; if (_sp > XB_SPIN_CAP) { atomicAdd(&(bar)[XB_TMO], 1u); break; } } } } while (0)
struct XcdBarrier { unsigned* bar; unsigned x; volatile LAS unsigned* st; };
__device__ __forceinline__ XcdBarrier xcd_barrier_post(unsigned* bar, volatile LAS unsigned* st) {
    XcdBarrier b; b.bar = bar; b.x = xb_xcc_id(); b.st = st;
    if (threadIdx.x == 0) (void)xb_add(&bar[XB_XCNT(b.x)], 1u);
    return b;
}
__device__ __forceinline__ void xcd_barrier_complete(unsigned* bar, unsigned x, unsigned& nloc, unsigned& nx) {
    const unsigned G = gridDim.x * gridDim.y * gridDim.z;
    unsigned sum, cnt, mine, sp = 0u;
    for (;;) {
        sum = 0u; cnt = 0u; mine = 0u;
#pragma unroll
        for (unsigned j = 0; j < 16; ++j) { const unsigned c = xb_ld(&bar[XB_XCNT(j)]); sum += c; cnt += (c > 0u) ? 1u : 0u; mine = (j == x) ? c : mine; }
        if (sum == G) break;
        __builtin_amdgcn_s_sleep(1);
        if ((++sp & 255u) == 0u) { if (xb_ld(&bar[XB_TMO])) break; if (sp > XB_SPIN_CAP) { atomicAdd(&bar[XB_TMO], 1u); break; } }
    }
    nloc = mine > 0u ? mine : 1u; nx = cnt > 0u ? cnt : 1u;
}
__device__ __forceinline__ void xcd_barrier(const XcdBarrier& b) {
    asm volatile("s_waitcnt vmcnt(0)" ::: "memory");
    __syncthreads();
    if (threadIdx.x == 0) {
        unsigned* bar = b.bar;
        __builtin_amdgcn_s_waitcnt(0);
        unsigned nloc = b.st[0], nx = b.st[1];
        if (nloc == 0u) { xcd_barrier_complete(bar, b.x, nloc, nx); b.st[0] = nloc; b.st[1] = nx; }
        const unsigned old = xb_add(&bar[XB_XSUB(b.x)], 1u);
        const unsigned gen = old / nloc;
        if (old + 1u == (gen + 1u) * nloc) {
            __builtin_amdgcn_fence(__ATOMIC_RELEASE, "agent");
            asm volatile("s_waitcnt vmcnt(0)" ::: "memory");
            const unsigned og = xb_add(&bar[XB_TOP], 1u);
            const unsigned tg = og / nx;
            if (og + 1u == (tg + 1u) * nx) xb_add(&bar[XB_TOPGEN], 1u);
            else XB_SPIN(xb_ld(&bar[XB_TOPGEN]) == tg, bar);
            __builtin_amdgcn_fence(__ATOMIC_ACQUIRE, "agent");
            xb_add(&bar[XB_XGEN(b.x)], 1u);
            asm volatile("s_waitcnt vmcnt(0)" ::: "memory");
        } else {
            XB_SPIN(xb_ld(&bar[XB_XGEN(b.x)]) == gen, bar);
            __builtin_amdgcn_fence(__ATOMIC_ACQUIRE, "agent");
            asm volatile("s_waitcnt vmcnt(0)" ::: "memory");
        }
    }
    __syncthreads();
}

__device__ __forceinline__ float wave_sum(float v) {
#pragma unroll
    for (int o = 1; o < 64; o <<= 1) v += __shfl_xor(v, o);
    return v;
}

namespace pg8 {
#define PG8_LAS __attribute__((address_space(3)))
typedef unsigned short bf16_t;
typedef short bf16x8 __attribute__((ext_vector_type(8)));
typedef float f32x4 __attribute__((ext_vector_type(4)));
typedef float f32x2 __attribute__((ext_vector_type(2)));
typedef unsigned u32x4 __attribute__((ext_vector_type(4)));
typedef unsigned u32x2 __attribute__((ext_vector_type(2)));
constexpr int BM = 256, BK = 64, HALF = 128, HTB = HALF * BK * 2  , STAGE_BYTES = 8 * HTB, NXCD = 8, WGM = 8;

__host__ __device__ __forceinline__ int lds_byte(int r, int c) { const int st = (r >> 4) * 2 + (c >> 5), rr = r & 15, cc = c & 31, ob = rr * 64 + cc * 2; return st * 1024 + (ob ^ (((ob >> 9) & 1) << 5)); }
__host__ __device__ __forceinline__ void stage_rc(int b, int& R, int& C) { const int st = b / 1024, sb = b % 1024, swz = sb ^ (((sb >> 9) & 1) << 5); R = (st >> 1) * 16 + swz / 64; C = (st & 1) * 32 + (swz % 64) / 2; }
__host__ __device__ __forceinline__ int perm32(int rho) { const int n = rho >> 4, i = rho & 15; return 8 * (i >> 2) + 4 * n + (i & 3); }

struct Unit { int pm, pn, aux, aux2, aux3; };

struct StaticOrder {
    const bf16_t* A; const bf16_t* Bt; int K;
    int nM, nN, nwg, G, c;
    __device__ void init(const bf16_t* A_, const bf16_t* Bt_, int M, int N, int K_, int G_, int c_) { A = A_; Bt = Bt_; K = K_; nM = M / BM; nN = N / BM; nwg = nM * nN; G = G_; c = c_; }
    __device__ bool next(int i, Unit& u) const {
        const long L = (long)i * G + c; if (L >= nwg) return false;
        int wgid = (int)L; { const int q = nwg / NXCD, r = nwg % NXCD, xcd = wgid % NXCD, off = wgid / NXCD; wgid = (xcd < r ? xcd * (q + 1) : r * (q + 1) + (xcd - r) * q) + off; }
        const int nig = WGM * nN, gid = wgid / nig, fm = gid * WGM, gsz = (nM - fm) < WGM ? (nM - fm) : WGM;
        u.pm = fm + ((wgid % nig) % gsz); u.pn = (wgid % nig) / gsz; u.aux = 256; u.aux2 = u.pm * 256; u.aux3 = 0; return true;
    }
    __device__ __forceinline__ const char* a_base(const Unit& u) const { return (const char*)A + (size_t)u.pm * 256 * K * 2; }
    __device__ __forceinline__ const char* b_base(const Unit& u) const { return (const char*)Bt + (size_t)u.pn * 256 * K * 2; }
    __device__ __forceinline__ unsigned a_off(int, int, int) const { return 0u; }
};

__device__ __forceinline__ unsigned cvt_pk_bf16(float lo, float hi) { unsigned r; asm volatile("v_cvt_pk_bf16_f32 %0, %1, %2" : "=v"(r) : "v"(lo), "v"(hi)); return r; }
__device__ __forceinline__ float bf_lo(unsigned w) { return __uint_as_float(w << 16); }
__device__ __forceinline__ float bf_hi(unsigned w) { return __uint_as_float(w & 0xffff0000u); }
__device__ __forceinline__ float sigmoidf_(float x) { return __builtin_amdgcn_rcpf(1.0f + __builtin_amdgcn_exp2f(-1.4426950408889634f * x)); }
__device__ __forceinline__ float siluf_(float x) { return x * sigmoidf_(x); }

template <class Epi, class Sched, bool ALIGN_EPI = false, bool SP2 = false, bool GA = false>
__device__ __forceinline__ void gemm_phase(PG8_LAS unsigned char* lds, const int K, const Sched& S, const Epi& E) {
    const int tid = threadIdx.x, wid = __builtin_amdgcn_readfirstlane(tid >> 6), lane = tid & 63, wr = wid >> 2, wc = wid & 3, fr = lane & 15, fq = lane >> 4;
    const int nt = K / BK;
    unsigned voffA[2], voffB[2];
#pragma unroll
    for (int i = 0; i < 2; ++i) { int R, C; stage_rc(tid * 16 + i * 8192, R, C); const int Rb = Epi::PERM ? ((R & ~31) + perm32(R & 31)) : R;
        voffA[i] = (unsigned)(R * K + C) * 2u; voffB[i] = (unsigned)(Rb * K + C) * 2u; }
    const size_t kstep = (size_t)(BK * 2);
    const size_t hstep = (size_t)HALF * K * 2;
    const size_t hstepA = GA ? 0 : hstep;
    const unsigned ldsw = (unsigned)wid * 1024u;
    const int aoff = lds_byte(wr * 64 + fr, fq * 8), boff = lds_byte(wc * 32 + fr, fq * 8);
#define PG8_SA(b, h) (((b) * 2 + (h)) * HTB)
#define PG8_SB(b, h) ((4 + (b) * 2 + (h)) * HTB)
#define PG8_STAGE(bufoff, gbase, voff) do { _Pragma("unroll") for (int _i = 0; _i < 2; ++_i) \
        __builtin_amdgcn_global_load_lds((const unsigned*)((const char*)(gbase) + (voff)[_i]), (PG8_LAS unsigned*)(lds + (bufoff) + ldsw + _i * 8192), 16, 0, 0); } while (0)
#define PG8_LDA(dst, b, h) do { _Pragma("unroll") for (int m = 0; m < 4; ++m) _Pragma("unroll") for (int k = 0; k < 2; ++k) dst[m][k] = *(const PG8_LAS bf16x8*)(lds + PG8_SA(b, h) + aoff + m * 2048 + k * 1024); } while (0)
#define PG8_LDB(dst, b, h) do { _Pragma("unroll") for (int n = 0; n < 2; ++n) _Pragma("unroll") for (int k = 0; k < 2; ++k) dst[n][k] = *(const PG8_LAS bf16x8*)(lds + PG8_SB(b, h) + boff + n * 2048 + k * 1024); } while (0)
#define PG8_MMA(ai, bj, At, Bt) do { __builtin_amdgcn_s_setprio(1); _Pragma("unroll") for (int m = 0; m < 4; ++m) _Pragma("unroll") for (int n = 0; n < 2; ++n) _Pragma("unroll") for (int k = 0; k < 2; ++k) \
        acc[ai][bj][m][n] = __builtin_amdgcn_mfma_f32_16x16x32_bf16(Bt[n][k], At[m][k], acc[ai][bj][m][n], 0, 0, 0); __builtin_amdgcn_s_setprio(0); } while (0)
#define PG8_WAIT_V(n) asm volatile("s_waitcnt vmcnt(" #n ")" ::: "memory")
#define PG8_WAIT_L(n) asm volatile("s_waitcnt lgkmcnt(" #n ")" ::: "memory")
#define PG8_BAR __builtin_amdgcn_s_barrier()
#define PG8_SCHED __builtin_amdgcn_sched_barrier(0)
    Unit cur, nxt; int ui = 0;
    if (!S.next(0, cur)) return;
    f32x4 acc[2][2][4][2];
#pragma unroll
    for (int a = 0; a < 2; ++a)
#pragma unroll
        for (int b = 0; b < 2; ++b)
#pragma unroll
            for (int m = 0; m < 4; ++m)
#pragma unroll
                for (int n = 0; n < 2; ++n) acc[a][b][m][n] = (f32x4){0.f, 0.f, 0.f, 0.f};
    bf16x8 At[4][2], B0[2][2], B1[2][2];
    const char* cA = S.a_base(cur); const char* cB = S.b_base(cur);
#define PG8_STAGE_A(bufoff, gbase, h, PMX) do { if constexpr (GA) { int t_ = (int)__builtin_amdgcn_mbcnt_hi(~0u, __builtin_amdgcn_mbcnt_lo(~0u, 0u)); asm volatile("" : "+v"(t_)); t_ += wid * 64; \
        unsigned vg_[2]; _Pragma("unroll") for (int _j = 0; _j < 2; ++_j) { int R_, C_; stage_rc(t_ * 16 + _j * 8192, R_, C_); vg_[_j] = S.a_off(PMX, (h) * HALF + R_, C_); } PG8_STAGE(bufoff, gbase, vg_); } \
        else { PG8_STAGE(bufoff, (gbase) + (h) * hstep, voffA); } } while (0)
    if constexpr (SP2) {
        PG8_STAGE(PG8_SB(0, 0), cB, voffB); PG8_STAGE(PG8_SB(0, 1), cB + hstep, voffB); PG8_STAGE_A(PG8_SA(0, 0), cA, 0, cur.pm); PG8_STAGE_A(PG8_SA(0, 1), cA, 1, cur.pm);
        if (wr == 1) PG8_BAR;
        PG8_WAIT_V(2); PG8_BAR;
        PG8_STAGE(PG8_SB(1, 0), cB + kstep, voffB); PG8_STAGE_A(PG8_SA(1, 0), cA + kstep, 0, cur.pm); PG8_STAGE(PG8_SB(1, 1), cB + hstep + kstep, voffB);
        PG8_WAIT_V(6); PG8_BAR;
    } else {
        PG8_STAGE(PG8_SB(0, 0), cB, voffB); PG8_STAGE_A(PG8_SA(0, 0), cA, 0, cur.pm); PG8_STAGE(PG8_SB(0, 1), cB + hstep, voffB); PG8_STAGE_A(PG8_SA(0, 1), cA, 1, cur.pm);
        if (wr == 1) PG8_BAR;
        PG8_WAIT_V(4); PG8_BAR;
        PG8_STAGE(PG8_SB(1, 0), cB + kstep, voffB); PG8_STAGE_A(PG8_SA(1, 0), cA + kstep, 0, cur.pm); PG8_STAGE(PG8_SB(1, 1), cB + hstep + kstep, voffB);
        PG8_WAIT_V(6); PG8_BAR;
    }
#pragma unroll 1
    for (;;) {
        const bool has_next = S.next(ui + 1, nxt);
        const char* nA = has_next ? S.a_base(nxt) : cA; const char* nB = has_next ? S.b_base(nxt) : cB;
#pragma unroll 1
        for (int t = 0; t < nt; t += 2) {
            const bool last = (t == nt - 2);
            const char* a1 = cA + (size_t)(t + 1) * kstep;
            const char* a2 = last ? nA : cA + (size_t)(t + 2) * kstep; const char* b2 = last ? nB : cB + (size_t)(t + 2) * kstep;
            const char* a3 = a2 + kstep; const char* b3 = b2 + kstep;
            const int pm2 = (last && has_next) ? nxt.pm : cur.pm;
            if constexpr (SP2) {
            PG8_LDB(B0, 0, 0); PG8_LDB(B1, 0, 1); PG8_SCHED; PG8_LDA(At, 0, 0); PG8_STAGE_A(PG8_SA(1, 1), a1, 1, cur.pm);
            PG8_WAIT_V(8); PG8_WAIT_L(0); PG8_BAR; PG8_MMA(0, 0, At, B0); PG8_MMA(0, 1, At, B1); PG8_BAR; PG8_SCHED;
            PG8_LDA(At, 0, 1); PG8_STAGE(PG8_SB(0, 0), b2, voffB); PG8_STAGE(PG8_SB(0, 1), b2 + hstep, voffB); PG8_STAGE_A(PG8_SA(0, 0), a2, 0, pm2);
            PG8_WAIT_V(8); PG8_WAIT_L(0); PG8_BAR; PG8_MMA(1, 0, At, B0); PG8_MMA(1, 1, At, B1); PG8_BAR; PG8_SCHED;
            PG8_LDB(B0, 1, 0); PG8_LDB(B1, 1, 1); PG8_SCHED; PG8_LDA(At, 1, 0); PG8_STAGE_A(PG8_SA(0, 1), a2, 1, pm2);
            PG8_WAIT_V(8); PG8_WAIT_L(0); PG8_BAR; PG8_MMA(0, 0, At, B0); PG8_MMA(0, 1, At, B1); PG8_BAR; PG8_SCHED;
            PG8_LDA(At, 1, 1); PG8_STAGE(PG8_SB(1, 0), b3, voffB); PG8_STAGE(PG8_SB(1, 1), b3 + hstep, voffB); PG8_STAGE_A(PG8_SA(1, 0), a3, 0, pm2);
            PG8_WAIT_V(8); PG8_WAIT_L(0); PG8_BAR; PG8_MMA(1, 0, At, B0); PG8_MMA(1, 1, At, B1); PG8_BAR; PG8_SCHED;
            } else {
            PG8_LDB(B0, 0, 0); PG8_SCHED; PG8_LDA(At, 0, 0); PG8_STAGE_A(PG8_SA(1, 1), a1, 1, cur.pm);
            PG8_WAIT_L(8); PG8_BAR; PG8_WAIT_L(0); PG8_MMA(0, 0, At, B0); PG8_BAR; PG8_SCHED;
            PG8_LDB(B1, 0, 1); PG8_STAGE(PG8_SB(0, 0), b2, voffB);
            PG8_BAR; PG8_WAIT_L(0); PG8_MMA(0, 1, At, B1); PG8_BAR;
            PG8_LDA(At, 0, 1); PG8_STAGE_A(PG8_SA(0, 0), a2, 0, pm2);
            PG8_BAR; PG8_WAIT_L(0); PG8_MMA(1, 0, At, B0); PG8_BAR; PG8_SCHED;
            PG8_STAGE(PG8_SB(0, 1), b2 + hstep, voffB);
            PG8_WAIT_V(6); PG8_BAR; PG8_MMA(1, 1, At, B1); PG8_BAR;
            PG8_LDB(B0, 1, 0); PG8_SCHED; PG8_LDA(At, 1, 0); PG8_STAGE_A(PG8_SA(0, 1), a2, 1, pm2);
            PG8_WAIT_L(8); PG8_BAR; PG8_WAIT_L(0); PG8_MMA(0, 0, At, B0); PG8_BAR; PG8_SCHED;
            PG8_LDB(B1, 1, 1); PG8_STAGE(PG8_SB(1, 0), b3, voffB);
            PG8_BAR; PG8_WAIT_L(0); PG8_MMA(0, 1, At, B1); PG8_BAR;
            PG8_LDA(At, 1, 1); PG8_STAGE_A(PG8_SA(1, 0), a3, 0, pm2);
            PG8_BAR; PG8_WAIT_L(0); PG8_MMA(1, 0, At, B0); PG8_BAR; PG8_SCHED;
            PG8_STAGE(PG8_SB(1, 1), b3 + hstep, voffB);
            PG8_WAIT_V(6); PG8_BAR; PG8_MMA(1, 1, At, B1); PG8_BAR;
            }
        }
        if constexpr (ALIGN_EPI) { if (wr == 0) PG8_BAR; }
        E(acc, cur, wr, wc, fr, fq);
        if (!has_next) break;
#pragma unroll
        for (int a = 0; a < 2; ++a)
#pragma unroll
            for (int b = 0; b < 2; ++b)
#pragma unroll
                for (int m = 0; m < 4; ++m)
#pragma unroll
                    for (int n = 0; n < 2; ++n) acc[a][b][m][n] = (f32x4){0.f, 0.f, 0.f, 0.f};
        cur = nxt; cA = nA; cB = nB; ++ui;
        if constexpr (ALIGN_EPI) { if (wr == 1) PG8_BAR; }
    }
    PG8_WAIT_V(0);
    if constexpr (!ALIGN_EPI) { if (wr == 0) PG8_BAR; }
    PG8_BAR;
#undef PG8_SA
#undef PG8_SB
#undef PG8_STAGE
#undef PG8_STAGE_A
#undef PG8_LDA
#undef PG8_LDB
#undef PG8_MMA
#undef PG8_WAIT_V
#undef PG8_WAIT_L
#undef PG8_BAR
#undef PG8_SCHED
}
}

struct Args { const void* in[24]; float* out; unsigned char* ws; int ph_lo, ph_hi; };
enum { I_X = 0, I_P, I_POS, I_WIN, I_WGK2, I_BGK, I_GNORM, I_WGO, I_WMO, I_WOUT, I_LN1G, I_LN1B, I_WR, I_BR, I_WEG, I_WEU, I_WED, I_WSG, I_WSU, I_WSD, I_WPLE, I_WPG, I_LN2G, I_LN2B };

__device__ __forceinline__ void p0_transpose_item(const float* W, int ldw, int src_c0, int K, bf16* dst, int k0, LAS float* scr, int lane) {
#pragma unroll 8
    for (int i = 0; i < 32; ++i) { const int kk = 2 * i + (lane >> 5); scr[kk * 33 + (lane & 31)] = W[(size_t)(k0 + kk) * ldw + src_c0 + (lane & 31)]; }
    LDS_WAIT(); asm volatile("" ::: "memory");
    const int c = lane & 7;
#pragma unroll
    for (int j = 0; j < 4; ++j) { const int n = (lane >> 3) + 8 * j; const LAS float* s = scr + (8 * c) * 33 + n;
        v4u o; o.x = pk2(s[0 * 33], s[1 * 33]); o.y = pk2(s[2 * 33], s[3 * 33]); o.z = pk2(s[4 * 33], s[5 * 33]); o.w = pk2(s[6 * 33], s[7 * 33]);
        *(GAS v4u*)(dst + (size_t)n * K + k0 + 8 * c) = o; }
    LDS_WAIT(); asm volatile("" ::: "memory");
}

__device__ __forceinline__ void phase0(const Args& a, LAS unsigned char* lds, int vcu, int G) {
    const int tid = threadIdx.x, lane = tid & 63, wave = __builtin_amdgcn_readfirstlane(tid >> 6);
    unsigned char* ws = a.ws;
    LAS float* scr = (LAS float*)(lds + RING_OFF + wave * 16384);
    const int gw = vcu * NWAVES + wave, NGW = G * NWAVES;
    constexpr int IT_IN = 16 * 257;
    constexpr int IT_SQ = 16 * 32;
    constexpr int IT_R = 16 * 8, IT_P = 4 * 32, IT_S1 = 16 * 16, IT_S2 = 4 * 32;
    constexpr int IT_E1 = 16 * 16, IT_E2 = 4 * 32;
    constexpr int N_SMALL = IT_IN + 4 * IT_SQ + IT_R + IT_P + IT_S1 + IT_S2;
    constexpr int N_ALL = N_SMALL + NEXP * (IT_E1 + IT_E2);
    for (int it = gw; it < N_ALL; it += NGW) {
        int r = it;
        if (r < IT_IN) { const int kb = r / 257, nb = r % 257, n0 = nb * 32; const int src = (n0 < 3072) ? n0 : ((n0 < 8192) ? n0 + 16 : 3072);
            p0_transpose_item((const float*)a.in[I_WIN], IN_COLS, src, 1024, (bf16*)(ws + WS_WIN) + (size_t)n0 * 1024, kb * 64, scr, lane); continue; } r -= IT_IN;
        if (r < 4 * IT_SQ) { const int w = r / IT_SQ, q = r % IT_SQ, kb = q / 32, nb = q % 32;
            const float* src = (const float*)a.in[w == 0 ? I_WGO : (w == 1 ? I_WMO : (w == 2 ? I_WOUT : I_WPG))];
            bf16* dst = (bf16*)(ws + (w == 0 ? WS_WGO : (w == 1 ? WS_WMO : (w == 2 ? WS_WOUT : WS_WPG))));
            p0_transpose_item(src, 1024, nb * 32, 1024, dst + (size_t)nb * 32 * 1024, kb * 64, scr, lane); continue; } r -= 4 * IT_SQ;
        if (r < IT_R) { const int kb = r / 8, nb = r % 8; p0_transpose_item((const float*)a.in[I_WR], 256, nb * 32, 1024, (bf16*)(ws + WS_WR) + (size_t)nb * 32 * 1024, kb * 64, scr, lane); continue; } r -= IT_R;
        if (r < IT_P) { const int kb = r / 32, nb = r % 32; p0_transpose_item((const float*)a.in[I_WPLE], 1024, nb * 32, 256, (bf16*)(ws + WS_WP) + (size_t)nb * 32 * 256, kb * 64, scr, lane); continue; } r -= IT_P;
        if (r < IT_S1) { const int kb = r / 16, nb = r % 16, n0 = nb * 32, j = n0 >> 8, half = (n0 >> 7) & 1, c0 = n0 & 127;
            p0_transpose_item((const float*)a.in[half ? I_WSU : I_WSG], 256, 128 * j + c0, 1024, (bf16*)(ws + WS_WS1) + (size_t)n0 * 1024, kb * 64, scr, lane); continue; } r -= IT_S1;
        if (r < IT_S2) { const int kb = r / 32, nb = r % 32; p0_transpose_item((const float*)a.in[I_WSD], 1024, nb * 32, 256, (bf16*)(ws + WS_WS2) + (size_t)nb * 32 * 256, kb * 64, scr, lane); continue; } r -= IT_S2;
        { const int e = r / (IT_E1 + IT_E2); int q = r % (IT_E1 + IT_E2);
          if (q < IT_E1) { const int kb = q / 16, nb = q % 16, n0 = nb * 32, j = n0 >> 8, half = (n0 >> 7) & 1, c0 = n0 & 127;
              p0_transpose_item((const float*)a.in[half ? I_WEU : I_WEG] + (size_t)e * 1024 * 256, 256, 128 * j + c0, 1024, (bf16*)(ws + WS_WE1) + ((size_t)e * 512 + n0) * 1024, kb * 64, scr, lane); }
          else { q -= IT_E1; const int kb = q / 32, nb = q % 32;
              p0_transpose_item((const float*)a.in[I_WED] + (size_t)e * 256 * 1024, 1024, nb * 32, 256, (bf16*)(ws + WS_WE2) + ((size_t)e * 1024 + nb * 32) * 256, kb * 64, scr, lane); } }
    }
    const int gt = vcu * (NWAVES * 64) + tid, NGT = G * NWAVES * 64;
    { const f32x4* x4 = (const f32x4*)a.in[I_X]; v2u* o = (v2u*)(ws + WS_XB);
      for (int i = gt; i < M * DM / 4; i += NGT) { const f32x4 v = x4[i]; v2u w; w.x = pk2(v[0], v[1]); w.y = pk2(v[2], v[3]); o[i] = w; } }
    { const f32x4* p4 = (const f32x4*)a.in[I_P]; v2u* o = (v2u*)(ws + WS_PB);
      for (int i = gt; i < M * PLE_DIM / 4; i += NGT) { const f32x4 v = p4[i]; v2u w; w.x = pk2(v[0], v[1]); w.y = pk2(v[2], v[3]); o[i] = w; } }
    { const int* pos = (const int*)a.in[I_POS]; float* cs = (float*)(ws + WS_CS);
      for (int i = gt; i < M * 16; i += NGT) { const int row = i >> 4, f = i & 15;
          const double inv = exp2(-(double)f * (18.931568569324174 / 16.0));
          const double rev = (double)pos[row] * inv * 0.15915494309189535;
          const float fr = (float)(rev - floor(rev));
          cs[row * 32 + f] = __builtin_amdgcn_cosf(fr); cs[row * 32 + 16 + f] = __builtin_amdgcn_sinf(fr); } }
}

namespace epi {
using pg8::f32x4; using pg8::Unit; using pg8::cvt_pk_bf16; using pg8::u32x4; using pg8::u32x2; using pg8::bf_lo; using pg8::bf_hi; using pg8::sigmoidf_; using pg8::siluf_;
constexpr int HALF = 128;
__device__ __forceinline__ u32x4 pack8(f32x4 a, f32x4 b) { u32x4 w; w.x = cvt_pk_bf16(a[0], a[1]); w.y = cvt_pk_bf16(a[2], a[3]); w.z = cvt_pk_bf16(b[0], b[1]); w.w = cvt_pk_bf16(b[2], b[3]); return w; }
__device__ __forceinline__ void unpack8(u32x4 w, f32x4& a, f32x4& b) { a = (f32x4){bf_lo(w.x), bf_hi(w.x), bf_lo(w.y), bf_hi(w.y)}; b = (f32x4){bf_lo(w.z), bf_hi(w.z), bf_lo(w.w), bf_hi(w.w)}; }

struct EpiProj {
    static constexpr bool PERM = true;
    bf16* proj; float* low; const float* cs;
    __device__ __forceinline__ void operator()(const f32x4 (&acc)[2][2][4][2], const Unit& u, int wr, int wc, int fr, int fq) const {
        const int row0 = u.pm * 256 + wr * 64 + fr;
        const int pn = u.pn;
        if (pn == 32) {
            if (wc == 0 && fq < 2) {
#pragma unroll
                for (int ai = 0; ai < 2; ++ai)
#pragma unroll
                    for (int m = 0; m < 4; ++m) { float* d = low + (size_t)(row0 + ai * HALF + m * 16) * 16 + 8 * fq;
                        *(f32x4*)d = acc[ai][0][m][0]; *(f32x4*)(d + 4) = acc[ai][0][m][1]; }
            }
            return;
        }
        const int mode = (pn >= 8 && pn < 12) ? 1 : ((pn >= 24) ? 2 : ((pn >= 12 && pn < 20) ? 3 : 0));
        const int col0 = pn * 256 + wc * 32 + 8 * fq;
#pragma unroll
        for (int ai = 0; ai < 2; ++ai)
#pragma unroll
            for (int m = 0; m < 4; ++m) {
                const int row = row0 + ai * HALF + m * 16;
                bf16* rowp = proj + (size_t)row * PP + col0;
#pragma unroll
                for (int bj = 0; bj < 2; ++bj) {
                    f32x4 v0 = acc[ai][bj][m][0], v1 = acc[ai][bj][m][1];
                    if (mode == 1) {
#pragma unroll
                        for (int i = 0; i < 4; ++i) { v0[i] = siluf_(v0[i]); v1[i] = siluf_(v1[i]); }
                    } else if (mode == 2) {
#pragma unroll
                        for (int i = 0; i < 4; ++i) { v0[i] = sigmoidf_(v0[i]); v1[i] = sigmoidf_(v1[i]); }
                    } else if (mode == 3) {
                        if (wc == 0) {
                            const float* c = cs + (size_t)row * 32 + 8 * (fq & 1);
                            const f32x4 c0 = *(const f32x4*)c, c1 = *(const f32x4*)(c + 4), s0 = *(const f32x4*)(c + 16), s1 = *(const f32x4*)(c + 20);
                            f32x4 p0, p1;
#pragma unroll
                            for (int i = 0; i < 4; ++i) { p0[i] = __shfl_xor(v0[i], 32); p1[i] = __shfl_xor(v1[i], 32); }
                            if (fq < 2) { v0 = v0 * c0 - p0 * s0; v1 = v1 * c1 - p1 * s1; }
                            else        { v0 = p0 * s0 + v0 * c0; v1 = p1 * s1 + v1 * c1; }
                        }
                    }
                    *(u32x4*)(rowp + bj * HALF) = pack8(v0, v1);
                }
            }
    }
};

template <bool ROWBASE> struct EpiBf16 {
    static constexpr bool PERM = true;
    bf16* O; int ld;
    __device__ __forceinline__ void operator()(const f32x4 (&acc)[2][2][4][2], const Unit& u, int wr, int wc, int fr, int fq) const {
        const int rb = ROWBASE ? u.aux2 : u.pm * 256; const int col0 = u.pn * 256 + wc * 32 + 8 * fq;
#pragma unroll
        for (int ai = 0; ai < 2; ++ai)
#pragma unroll
            for (int m = 0; m < 4; ++m) { const int r = ai * HALF + wr * 64 + m * 16 + fr; if (r < u.aux) { bf16* rowp = O + (size_t)(rb + r) * ld + col0;
#pragma unroll
                for (int bj = 0; bj < 2; ++bj) *(u32x4*)(rowp + bj * HALF) = pack8(acc[ai][bj][m][0], acc[ai][bj][m][1]); } }
    }
};

template <bool ADD> struct EpiGate {
    static constexpr bool PERM = true;
    bf16* merged; const bf16* gate;
    __device__ __forceinline__ void operator()(const f32x4 (&acc)[2][2][4][2], const Unit& u, int wr, int wc, int fr, int fq) const {
        const int col0 = u.pn * 256 + wc * 32 + 8 * fq;
#pragma unroll
        for (int ai = 0; ai < 2; ++ai)
#pragma unroll
            for (int m = 0; m < 4; ++m) { const int row = u.pm * 256 + ai * HALF + wr * 64 + m * 16 + fr;
#pragma unroll
                for (int bj = 0; bj < 2; ++bj) { const int c = col0 + bj * HALF;
                    f32x4 g0, g1; unpack8(*(const u32x4*)(gate + (size_t)row * PP + c), g0, g1);
                    f32x4 v0 = acc[ai][bj][m][0] * g0, v1 = acc[ai][bj][m][1] * g1;
                    bf16* d = merged + (size_t)row * DM + c;
                    if (ADD) { f32x4 o0, o1; unpack8(*(const u32x4*)d, o0, o1); v0 += o0; v1 += o1; }
                    *(u32x4*)d = pack8(v0, v1); } }
    }
};

struct EpiPre1 {
    static constexpr bool PERM = false;
    const float* x; float* pre;
    __device__ __forceinline__ void operator()(const f32x4 (&acc)[2][2][4][2], const Unit& u, int wr, int wc, int fr, int fq) const {
        const int col0 = u.pn * 256 + wc * 32 + 4 * fq;
#pragma unroll
        for (int ai = 0; ai < 2; ++ai)
#pragma unroll
            for (int m = 0; m < 4; ++m) { const size_t off = (size_t)(u.pm * 256 + ai * HALF + wr * 64 + m * 16 + fr) * DM + col0;
#pragma unroll
                for (int bj = 0; bj < 2; ++bj)
#pragma unroll
                    for (int n = 0; n < 2; ++n) { const size_t o = off + bj * HALF + n * 16; *(f32x4*)(pre + o) = *(const f32x4*)(x + o) * ALPHA + acc[ai][bj][m][n]; } }
    }
};

struct EpiF32 {
    static constexpr bool PERM = false;
    float* O; int ld;
    __device__ __forceinline__ void operator()(const f32x4 (&acc)[2][2][4][2], const Unit& u, int wr, int wc, int fr, int fq) const {
        const int col0 = u.pn * 256 + wc * 32 + 4 * fq;
#pragma unroll
        for (int ai = 0; ai < 2; ++ai)
#pragma unroll
            for (int m = 0; m < 4; ++m) { float* rowp = O + (size_t)(u.pm * 256 + ai * HALF + wr * 64 + m * 16 + fr) * ld + col0;
#pragma unroll
                for (int bj = 0; bj < 2; ++bj)
#pragma unroll
                    for (int n = 0; n < 2; ++n) *(f32x4*)(rowp + bj * HALF + n * 16) = acc[ai][bj][m][n]; }
    }
};

struct EpiSwiGLU {
    static constexpr bool PERM = true;
    bf16* H;
    __device__ __forceinline__ void operator()(const f32x4 (&acc)[2][2][4][2], const Unit& u, int wr, int wc, int fr, int fq) const {
        const int col0 = u.pn * 128 + wc * 32 + 8 * fq;
#pragma unroll
        for (int ai = 0; ai < 2; ++ai)
#pragma unroll
            for (int m = 0; m < 4; ++m) { const int r = ai * HALF + wr * 64 + m * 16 + fr; if (r < u.aux) {
                f32x4 g0 = acc[ai][0][m][0], g1 = acc[ai][0][m][1]; const f32x4 u0 = acc[ai][1][m][0], u1 = acc[ai][1][m][1];
#pragma unroll
                for (int i = 0; i < 4; ++i) { g0[i] = siluf_(g0[i]) * u0[i]; g1[i] = siluf_(g1[i]) * u1[i]; }
                *(u32x4*)(H + (size_t)(u.aux2 + r) * DEXP + col0) = pack8(g0, g1); } }
    }
};

struct EpiPle {
    static constexpr bool PERM = true;
    const bf16* pw; bf16* ple;
    __device__ __forceinline__ void operator()(const f32x4 (&acc)[2][2][4][2], const Unit& u, int wr, int wc, int fr, int fq) const {
        const int col0 = u.pn * 256 + wc * 32 + 8 * fq;
#pragma unroll
        for (int ai = 0; ai < 2; ++ai)
#pragma unroll
            for (int m = 0; m < 4; ++m) { const size_t off = (size_t)(u.pm * 256 + ai * HALF + wr * 64 + m * 16 + fr) * DM + col0;
#pragma unroll
                for (int bj = 0; bj < 2; ++bj) { f32x4 p0, p1; unpack8(*(const u32x4*)(pw + off + bj * HALF), p0, p1);
                    f32x4 v0 = acc[ai][bj][m][0], v1 = acc[ai][bj][m][1];
#pragma unroll
                    for (int i = 0; i < 4; ++i) { v0[i] = sigmoidf_(v0[i]) * p0[i]; v1[i] = sigmoidf_(v1[i]) * p1[i]; }
                    *(u32x4*)(ple + off + bj * HALF) = pack8(v0, v1); } }
    }
};

struct EpiDown {
    static constexpr bool PERM = true;
    bf16* Y; const float* w;
    __device__ __forceinline__ void operator()(const f32x4 (&acc)[2][2][4][2], const Unit& u, int wr, int wc, int fr, int fq) const {
        const int col0 = u.pn * 256 + wc * 32 + 8 * fq;
#pragma unroll
        for (int ai = 0; ai < 2; ++ai)
#pragma unroll
            for (int m = 0; m < 4; ++m) { const int r = ai * HALF + wr * 64 + m * 16 + fr; if (r < u.aux) {
                const float s = w ? w[u.aux3 + r] : 1.f; bf16* rowp = Y + (size_t)(u.aux2 + r) * DM + col0;
#pragma unroll
                for (int bj = 0; bj < 2; ++bj) *(u32x4*)(rowp + bj * HALF) = pack8(acc[ai][bj][m][0] * s, acc[ai][bj][m][1] * s); } }
    }
};
}

namespace moba {
constexpr int D = 128, NW = 8, QBLK = 32, KVBLK = 64, QB = NW * QBLK;
constexpr int PIN = PP, POUT = DM;
constexpr float SCALE = 0.08838834764831845f;
constexpr float THR = 8.f;
constexpr int SHM_V = KVBLK * D * 2, SHM_K = KVBLK * D * 2;
constexpr int LDS_BYTES = 2 * SHM_V + 2 * SHM_K + NW * 64 * 4 + NW * 64 * 4 + NW * 64 * 8 * 4;
typedef short bf16x8 __attribute__((ext_vector_type(8)));
typedef short s16x4 __attribute__((ext_vector_type(4)));
typedef float f32x16 __attribute__((ext_vector_type(16)));
typedef float f32x4 __attribute__((ext_vector_type(4)));
typedef unsigned u32x4 __attribute__((ext_vector_type(4)));

#define KSWZ(row, colB) ((row) * 256 + ((colB) ^ (((row) & 7) << 4)))
#define SBAR() __builtin_amdgcn_sched_barrier(0)
__device__ __forceinline__ int v_st(int k, int c) { const int kk = (k & ~0xC) | ((k & 4) << 1) | ((k & 8) >> 1); return ((kk >> 3) * 4 + (c >> 5)) * 512 + ((kk & 7) * 32 + (c & 31)) * 2; }
__device__ __forceinline__ int v_rd_base(int lane) { return ((lane & 3) << 3) | (((lane >> 2) & 3) << 6) | (((lane >> 4) & 1) << 5) | (((lane >> 5) & 1) << 8); }
constexpr int v_rd_off(int d0, int ks, int half) { return d0 * 512 + ks * 4096 + half * 2048; }
__device__ __forceinline__ int crow(int r, int hi) { return (r & 3) + 8 * (r >> 2) + 4 * hi; }
__device__ __forceinline__ unsigned cvtpk(float lo, float hi) { unsigned r; asm volatile("v_cvt_pk_bf16_f32 %0, %1, %2" : "=v"(r) : "v"(lo), "v"(hi)); return r; }
__device__ __forceinline__ bf16x8 load8(const bf16* p) { return *reinterpret_cast<const bf16x8*>(p); }
__device__ __forceinline__ void mask_tile(f32x16& p0, f32x16& p1, int dq) {
    const float NEG = -__builtin_inff();
#pragma unroll
    for (int r = 0; r < 16; ++r) {
        const int c = (r & 3) + 8 * (r >> 2);
        if (dq - c < 0) p0[r] = NEG;
        if (dq - c - 32 < 0) p1[r] = NEG;
    }
}
__device__ __forceinline__ void mask_all(f32x16& p0, f32x16& p1, bool off) {
    const float NEG = -__builtin_inff();
#pragma unroll
    for (int r = 0; r < 16; ++r) { if (off) p0[r] = NEG; if (off) p1[r] = NEG; }
}
__device__ __forceinline__ void partialSM(f32x16& p0, f32x16& p1, float& m_reg, float& mn, float& alpha) {
    float pmax = p0[0]; for (int r = 1; r < 16; ++r) pmax = fmaxf(pmax, p0[r]); for (int r = 0; r < 16; ++r) pmax = fmaxf(pmax, p1[r]);
    { auto rr = __builtin_amdgcn_permlane32_swap(__float_as_uint(pmax), __float_as_uint(pmax), false, false);
      pmax = fmaxf(__uint_as_float(rr[0]), __uint_as_float(rr[1])); }
    constexpr float C2 = 1.4426950408889634f * SCALE;
    if (__builtin_expect(__all((pmax - m_reg) * SCALE <= THR), 1)) { mn = m_reg; alpha = 1.f; }
    else { mn = fmaxf(m_reg, pmax); alpha = __builtin_amdgcn_exp2f((m_reg - mn) * C2); m_reg = mn; }
    const float mnL = -mn * C2;
    for (int r = 0; r < 16; ++r) p0[r] = fmaf(p0[r], C2, mnL); for (int r = 0; r < 16; ++r) p1[r] = fmaf(p1[r], C2, mnL);
    for (int r = 0; r < 16; ++r) p0[r] = __builtin_amdgcn_exp2f(p0[r]);
}
__device__ __forceinline__ void finishSM(f32x16& p0, f32x16& p1, float alpha, float& l_reg, bf16x8& pa0, bf16x8& pa1, bf16x8& pa2, bf16x8& pa3) {
    for (int r = 0; r < 16; ++r) p1[r] = __builtin_amdgcn_exp2f(p1[r]);
    float ps = 0; for (int r = 0; r < 16; ++r) ps += p0[r]; for (int r = 0; r < 16; ++r) ps += p1[r];
    { auto rr = __builtin_amdgcn_permlane32_swap(__float_as_uint(ps), __float_as_uint(ps), false, false);
      ps = __uint_as_float(rr[0]) + __uint_as_float(rr[1]); }
    l_reg = l_reg * alpha + ps;
#define PK4(P, B_, OUT) do { unsigned a0 = cvtpk(P[B_+0], P[B_+1]), a1 = cvtpk(P[B_+2], P[B_+3]);                          \
        unsigned b0 = cvtpk(P[B_+4], P[B_+5]), b1 = cvtpk(P[B_+6], P[B_+7]);                                             \
        auto r0 = __builtin_amdgcn_permlane32_swap(a0, b0, false, false); auto r1 = __builtin_amdgcn_permlane32_swap(a1, b1, false, false); \
        u32x4 w = {r0[0], r1[0], r0[1], r1[1]}; OUT = *reinterpret_cast<bf16x8*>(&w); } while (0)
    PK4(p0, 0, pa0); PK4(p0, 8, pa1); PK4(p1, 0, pa2); PK4(p1, 8, pa3);
#undef PK4
}
template <int KB>
__device__ __forceinline__ void qkt(f32x16& p0, f32x16& p1, const char* K_lds, int r32, int hi, const bf16x8* qr) {
    p0 = f32x16{}; p1 = f32x16{};
    const char* kb[4];
#pragma unroll
    for (int dd = 0; dd < 4; ++dd) kb[dd] = K_lds + KB * SHM_K + KSWZ(r32, (dd * 16 + hi * 8) * 2);
#pragma unroll
    for (int d0 = 0; d0 < 8; ++d0) { const char* a = kb[d0 & 3] + (d0 >> 2) * 128;
        bf16x8 b0 = *reinterpret_cast<const bf16x8*>(a);
        bf16x8 b1 = *reinterpret_cast<const bf16x8*>(a + 32 * 256);
        p0 = __builtin_amdgcn_mfma_f32_32x32x16_bf16(b0, qr[d0], p0, 0, 0, 0);
        p1 = __builtin_amdgcn_mfma_f32_32x32x16_bf16(b1, qr[d0], p1, 0, 0, 0); }
}
template <int VB>
__device__ __forceinline__ void pv_tile(f32x16* o, int vb0, bf16x8 pa0, bf16x8 pa1, bf16x8 pa2, bf16x8 pa3) {
#define TRRD(dst, off) asm volatile("ds_read_b64_tr_b16 %0, %1 offset:%2" : "=&v"(dst) : "v"(vb0), "i"(off) : "memory")
#define PV_D0(d0) do { s16x4 l0, l1, l2, l3, h0, h1, h2, h3; constexpr int b_ = VB * SHM_V + v_rd_off(d0, 0, 0);   \
        TRRD(l0, b_); TRRD(h0, b_ + 2048); TRRD(l1, b_ + 4096); TRRD(h1, b_ + 6144); TRRD(l2, b_ + 8192); TRRD(h2, b_ + 10240); TRRD(l3, b_ + 12288); TRRD(h3, b_ + 14336); \
        asm volatile("s_waitcnt lgkmcnt(0)" ::: "memory"); SBAR();   \
        o[d0] = __builtin_amdgcn_mfma_f32_32x32x16_bf16(pa0, (bf16x8){l0[0], l0[1], l0[2], l0[3], h0[0], h0[1], h0[2], h0[3]}, o[d0], 0, 0, 0);   \
        o[d0] = __builtin_amdgcn_mfma_f32_32x32x16_bf16(pa1, (bf16x8){l1[0], l1[1], l1[2], l1[3], h1[0], h1[1], h1[2], h1[3]}, o[d0], 0, 0, 0);   \
        o[d0] = __builtin_amdgcn_mfma_f32_32x32x16_bf16(pa2, (bf16x8){l2[0], l2[1], l2[2], l2[3], h2[0], h2[1], h2[2], h2[3]}, o[d0], 0, 0, 0);   \
        o[d0] = __builtin_amdgcn_mfma_f32_32x32x16_bf16(pa3, (bf16x8){l3[0], l3[1], l3[2], l3[3], h3[0], h3[1], h3[2], h3[3]}, o[d0], 0, 0, 0); } while (0)
    PV_D0(0); PV_D0(1); PV_D0(2); PV_D0(3);
#undef PV_D0
#undef TRRD
}

struct BlockRef { const bf16* Q; const bf16* K; const bf16* V; bf16* O; const float* KM; int P0; };
struct Seam { bf16x8 qr[8]; bf16x8 st_v0, st_v1, st_k0, st_k1; };

#define OPQ_TID(t_) int t_ = (int)__builtin_amdgcn_mbcnt_hi(~0u, __builtin_amdgcn_mbcnt_lo(~0u, 0u)); asm volatile("" : "+v"(t_)); t_ += wid * 64
#define VMW() asm volatile("s_waitcnt vmcnt(0)" ::: "memory")
#define VMWN(n) asm volatile("s_waitcnt vmcnt(%0)" :: "i"(n) : "memory")
#define SLOAD_H(Kp, Vp, k0) do { OPQ_TID(t_); const size_t o0_ = (size_t)((k0) + (t_ >> 4)) * PIN + (t_ & 15) * 8, o1_ = o0_ + (size_t)32 * PIN;      \
                         S.st_v0 = load8((Vp) + o0_); S.st_v1 = load8((Vp) + o1_); S.st_k0 = load8((Kp) + o0_); S.st_k1 = load8((Kp) + o1_); } while (0)
#define SWRITE_HK(bf) do { OPQ_TID(t_); const int kws_ = KSWZ(t_ >> 4, (t_ & 15) * 16); *(bf16x8*)(K_lds + (bf) * SHM_K + kws_) = S.st_k0; *(bf16x8*)(K_lds + (bf) * SHM_K + kws_ + 32 * 256) = S.st_k1; } while (0)
#define SWRITE_HV(bf) do { OPQ_TID(t_); const int v0_ = v_st(t_ >> 4, (t_ & 15) * 8), v1_ = v_st(32 + (t_ >> 4), (t_ & 15) * 8); *(bf16x8*)(V_lds + (bf) * SHM_V + v0_) = S.st_v0; *(bf16x8*)(V_lds + (bf) * SHM_V + v1_) = S.st_v1; } while (0)
#define SWRITE_H(bf) do { SWRITE_HV(bf); SWRITE_HK(bf); } while (0)

__device__ __forceinline__ void prime(const BlockRef& cur, char* lds, Seam& S) {
    const int tid = threadIdx.x, wid = __builtin_amdgcn_readfirstlane(tid >> 6), lane = tid & 63, r32 = lane & 31, hi = lane >> 5;
    char* K_lds = lds + 2 * SHM_V;
    for (int d0 = 0; d0 < 8; ++d0) S.qr[d0] = load8(cur.Q + (size_t)(wid * QBLK + r32) * PIN + d0 * 16 + hi * 8);
    SLOAD_H(cur.K, cur.V, 0); VMW(); SWRITE_HK(0);
    __syncthreads();
}

__device__ __forceinline__ unsigned select_blocks(const Seam& S, const float* KM, int qb, int hi, float* sj) {
#pragma unroll 1
    for (int j = 0; j < qb; ++j) {
        float a = 0.f;
#pragma unroll
        for (int d0 = 0; d0 < 8; ++d0) { const float* km = KM + j * 128 + d0 * 16 + hi * 8; const f32x4 k0 = *(const f32x4*)km, k1 = *(const f32x4*)(km + 4);
            const bf16x8 q = S.qr[d0];
#pragma unroll
            for (int i = 0; i < 4; ++i) { a = fmaf(__uint_as_float(((unsigned)(unsigned short)q[i]) << 16), k0[i], a); a = fmaf(__uint_as_float(((unsigned)(unsigned short)q[4 + i]) << 16), k1[i], a); } }
        a += __shfl_xor(a, 32);
        sj[j * 64] = a;
    }
    asm volatile("s_waitcnt lgkmcnt(0)" ::: "memory");
    unsigned sel = 0u;
#pragma unroll 1
    for (int j = 0; j < qb; ++j) { const float sv = sj[j * 64]; int rank = 0;
#pragma unroll 1
        for (int i = 0; i < qb; ++i) { const float si = sj[i * 64]; rank += (i != j && (si > sv || (si == sv && i < j))) ? 1 : 0; }
        if (rank < 3) sel |= 1u << j; }
    return sel;
}

__device__ __forceinline__ void block(const BlockRef& cur, const bf16* nxtQ, char* lds, Seam& S) {
    const int tid = threadIdx.x, wid = __builtin_amdgcn_readfirstlane(tid >> 6), lane = tid & 63, r32 = lane & 31, hi = lane >> 5;
    const int NT = (cur.P0 + QB) / KVBLK;
    const int qlo = cur.P0 + wid * QBLK, qm = qlo + r32 - 4 * hi;
    char* V_lds = lds; char* K_lds = lds + 2 * SHM_V;
    float* ws = (float*)(lds + 2 * SHM_V + 2 * SHM_K) + wid * 64; float* li_l = ws, * al_l = ws + 32;
    float m_reg = -1e30f, l_reg = 0; f32x16 o[4] = {};
    const int vb0 = (int)(uintptr_t)V_lds + v_rd_base(lane);
    const bf16* Kh = cur.K; const bf16* Vh = cur.V;
    unsigned sel; { int lane_o = lane; asm volatile("" : "+v"(lane_o));
      sel = select_blocks(S, cur.KM, cur.P0 >> 8, lane_o >> 5, (float*)(lds + 2 * SHM_V + 2 * SHM_K + 2 * NW * 64 * 4) + wid * 512 + lane_o); }
#define RESC(a) do { if (__any((a) < 1.f)) { if (hi == 0) al_l[r32] = (a); asm volatile("s_waitcnt lgkmcnt(0)" ::: "memory");              \
                     for (int d_ = 0; d_ < 4; ++d_) for (int r = 0; r < 16; ++r) o[d_][r] *= al_l[crow(r, hi)]; } } while (0)
#define KBASE(t) ((t) * KVBLK)
#define MASKT(P0_, P1_, t) do { const int kb_ = KBASE(t); if (kb_ + KVBLK - 1 > qlo) mask_tile(P0_, P1_, qm - kb_);      \
        if (kb_ < cur.P0) { const bool off_ = ((sel >> (kb_ >> 8)) & 1u) == 0u; if (__any(off_)) mask_all(P0_, P1_, off_); } } while (0)
    constexpr int NQL = 8;
#define SEAM_K0() do { VMWN(NQL); SWRITE_HK(0); SBAR(); } while (0)
    f32x16 pA0, pA1, pB0, pB1; float mnA, mnB, alA, alB; bf16x8 pa0, pa1, pa2, pa3;
    SWRITE_HV(0); SBAR();
    if (NT > 1) { SLOAD_H(Kh, Vh, KBASE(1)); }
    SBAR(); qkt<0>(pA0, pA1, K_lds, r32, hi, S.qr);
    MASKT(pA0, pA1, 0); partialSM(pA0, pA1, m_reg, mnA, alA);
    if (NT > 1) { VMW(); SWRITE_H(1); }
    __syncthreads();
#define HALF_STEP(PX0, PX1, mnX, alX, PY0, PY1, alY, t, KB, VB, SB) do {                                                      \
        SBAR(); qkt<KB>(PX0, PX1, K_lds, r32, hi, S.qr);                                                                     \
        finishSM(PY0, PY1, alY, l_reg, pa0, pa1, pa2, pa3); SBAR();                                                           \
        if ((t) + 1 < NT) { SLOAD_H(Kh, Vh, KBASE((t) + 1)); SBAR(); }                                                        \
        pv_tile<VB>(o, vb0, pa0, pa1, pa2, pa3); MASKT(PX0, PX1, (t)); partialSM(PX0, PX1, m_reg, mnX, alX);                  \
        __syncthreads();                                                                                                      \
        if ((t) + 1 < NT) { VMW(); SWRITE_H(SB); }                                                                            \
        RESC(alX); __syncthreads(); } while (0)
    for (int t = 1; t + 1 < NT; t += 2) {
        HALF_STEP(pB0, pB1, mnB, alB, pA0, pA1, alA, t, 1, 0, 0);
        HALF_STEP(pA0, pA1, mnA, alA, pB0, pB1, alB, t + 1, 0, 1, 1);
    }
    const bool even = (NT & 1) == 0;
    if (even) { SBAR(); qkt<1>(pB0, pB1, K_lds, r32, hi, S.qr); SBAR(); }
    SLOAD_H(cur.K, cur.V, 0); SBAR();
#pragma unroll
    for (int d0 = 0; d0 < 8; ++d0) S.qr[d0] = load8(nxtQ + (size_t)(wid * QBLK + r32) * PIN + d0 * 16 + hi * 8);
    SBAR();
    finishSM(pA0, pA1, alA, l_reg, pa0, pa1, pa2, pa3); SBAR();
    pv_tile<0>(o, vb0, pa0, pa1, pa2, pa3);
    if (even) { MASKT(pB0, pB1, NT - 1); partialSM(pB0, pB1, m_reg, mnB, alB); __syncthreads(); RESC(alB);
        finishSM(pB0, pB1, alB, l_reg, pa0, pa1, pa2, pa3); SBAR(); pv_tile<1>(o, vb0, pa0, pa1, pa2, pa3); }
    SBAR(); SEAM_K0();
    if (hi == 0) li_l[r32] = l_reg; asm volatile("s_waitcnt lgkmcnt(0)" ::: "memory");
    float rli[16];
#pragma unroll
    for (int r = 0; r < 16; ++r) rli[r] = __builtin_amdgcn_rcpf(li_l[crow(r, hi)]);
    bf16* Ow = cur.O + (size_t)(wid * QBLK) * POUT;
#pragma unroll
    for (int r = 0; r < 16; ++r) { const int orow = crow(r, hi);
#pragma unroll
        for (int d0 = 0; d0 < 4; ++d0) { const float v = o[d0][r] * rli[r];
            const float vn = __shfl_xor(v, 1);
            if ((r32 & 1) == 0) *(unsigned*)(Ow + (size_t)orow * POUT + d0 * 32 + r32) = cvtpk(v, vn); } }
    __syncthreads();
#undef RESC
#undef KBASE
#undef MASKT
#undef SEAM_K0
#undef HALF_STEP
}
#undef OPQ_TID
#undef VMW
#undef VMWN
#undef SLOAD_H
#undef SWRITE_HK
#undef SWRITE_HV
#undef SWRITE_H
#undef KSWZ
#undef SBAR
}

namespace gla {
typedef short bf16x8 __attribute__((ext_vector_type(8)));
typedef float f32x4 __attribute__((ext_vector_type(4)));
constexpr int PQ = 136, PT = 72;
constexpr int O_QE = 0, O_KE = O_QE + 64 * PQ * 2, O_KDT = O_KE + 64 * PQ * 2, O_VT = O_KDT + 128 * PT * 2, O_ATT = O_VT + 32 * PT * 2, O_ST = O_ATT + 64 * PT * 2,
              O_SEG = O_ST + 32 * PQ * 2, O_DEC = O_SEG + 8 * 128 * 4, O_LOW = O_DEC + 128 * 4, O_END = O_LOW + 64 * 16 * 4;
static_assert(O_END <= RING_BYTES, "gla LDS");
__device__ __forceinline__ f32x4 mma(bf16x8 a, bf16x8 b, f32x4 c) { return __builtin_amdgcn_mfma_f32_16x16x32_bf16(a, b, c, 0, 0, 0); }
template <int KK>
__device__ __forceinline__ f32x4 tile_mm(const LAS bf16* X, int px, int i0, const LAS bf16* Y, int py, int j0, f32x4 c, int l15, int lq) {
#pragma unroll
    for (int kk = 0; kk < KK; ++kk) {
        const bf16x8 a = *(const LAS bf16x8*)(X + (i0 + l15) * px + kk * 32 + lq * 8);
        const bf16x8 b = *(const LAS bf16x8*)(Y + (j0 + l15) * py + kk * 32 + lq * 8);
        c = mma(a, b, c);
    }
    return c;
}
__device__ __forceinline__ float logsigmoidf_(float x) { return fminf(x, 0.f) - __logf(1.f + __expf(-fabsf(x))); }

__device__ __forceinline__ void item(const Args& a, LAS unsigned char* lds, int b, int h, int es) {
    const int tid = threadIdx.x, lane = tid & 63, wave = __builtin_amdgcn_readfirstlane(tid >> 6), l15 = lane & 15, lq = lane >> 4;
    unsigned char* ws = a.ws;
    const bf16* proj = (const bf16*)(ws + WS_PROJ); const float* lowg = (const float*)(ws + WS_LOW); bf16* og = (bf16*)(ws + WS_OG);
    LAS bf16* QE = (LAS bf16*)(lds + O_QE); LAS bf16* KE = (LAS bf16*)(lds + O_KE); LAS bf16* KDT = (LAS bf16*)(lds + O_KDT); LAS bf16* VT = (LAS bf16*)(lds + O_VT);
    LAS bf16* ATT = (LAS bf16*)(lds + O_ATT); LAS bf16* ST = (LAS bf16*)(lds + O_ST); LAS float* SEG = (LAS float*)(lds + O_SEG); LAS float* DEC = (LAS float*)(lds + O_DEC); LAS float* LOWS = (LAS float*)(lds + O_LOW);
    const int dp = lane, cg = wave;
    float w2[16][2], bg[2];
    { const float* W2 = (const float*)a.in[I_WGK2] + h * 128 + 2 * dp; const float* BG = (const float*)a.in[I_BGK] + h * 128 + 2 * dp;
#pragma unroll
      for (int j = 0; j < 16; ++j) { w2[j][0] = W2[j * 512]; w2[j][1] = W2[j * 512 + 1]; }
      bg[0] = BG[0]; bg[1] = BG[1]; }
    for (int i = tid; i < 32 * PQ / 2; i += NWAVES * 64) ((LAS unsigned*)ST)[i] = 0u;
    f32x4 Sreg[2] = {(f32x4){0.f, 0.f, 0.f, 0.f}, (f32x4){0.f, 0.f, 0.f, 0.f}};
    const size_t rowbase = (size_t)b * SEQ;
    for (int n = 0; n < SEQ / 64; ++n) {
        const size_t r0 = rowbase + (size_t)n * 64;
        if (tid < 256) *(LAS f32x4*)(LOWS + tid * 4) = *(const f32x4*)(lowg + r0 * 16 + tid * 4);
        unsigned qv[8], kv[8];
#pragma unroll
        for (int i = 0; i < 8; ++i) { const bf16* p = proj + (r0 + 8 * cg + i) * PP + h * 128 + 2 * dp; qv[i] = *(const unsigned*)(p + C_GQ); kv[i] = *(const unsigned*)(p + C_GK); }
        v2u vv; { const int c = tid >> 3, e0 = (tid & 7) * 4; vv = *(const v2u*)(proj + (r0 + c) * PP + C_GV + h * 256 + es * 32 + e0); }
        LDS_WAIT(); __syncthreads();
        float bl[8][2];
        { float run0 = 0.f, run1 = 0.f;
#pragma unroll
          for (int i = 0; i < 8; ++i) { const LAS float* lw = LOWS + (8 * cg + i) * 16; float x0 = bg[0], x1 = bg[1];
#pragma unroll
              for (int j = 0; j < 16; ++j) { const float l = lw[j]; x0 = fmaf(l, w2[j][0], x0); x1 = fmaf(l, w2[j][1], x1); }
              run0 += logsigmoidf_(x0) * 0.0625f; run1 += logsigmoidf_(x1) * 0.0625f; bl[i][0] = run0; bl[i][1] = run1; }
          SEG[cg * 128 + 2 * dp] = run0; SEG[cg * 128 + 2 * dp + 1] = run1; }
        LDS_WAIT(); __syncthreads();
        { float off0 = 0.f, off1 = 0.f, tot0 = 0.f, tot1 = 0.f;
#pragma unroll
          for (int g = 0; g < 8; ++g) { const float s0 = SEG[g * 128 + 2 * dp], s1 = SEG[g * 128 + 2 * dp + 1]; if (g < cg) { off0 += s0; off1 += s1; } tot0 += s0; tot1 += s1; }
          unsigned kd0[4], kd1[4];
#pragma unroll
          for (int i = 0; i < 8; ++i) { const float b0 = bl[i][0] + off0, b1 = bl[i][1] + off1;
              const float q0 = pg8::bf_lo(qv[i]) * 0.08838834764831845f, q1 = pg8::bf_hi(qv[i]) * 0.08838834764831845f, k0 = pg8::bf_lo(kv[i]), k1 = pg8::bf_hi(kv[i]);
              const float e0 = __expf(b0), e1 = __expf(b1), i0 = __expf(-b0), i1 = __expf(-b1), d0 = __expf(tot0 - b0), d1 = __expf(tot1 - b1);
              *(LAS unsigned*)(QE + (8 * cg + i) * PQ + 2 * dp) = pk2(q0 * e0, q1 * e1);
              *(LAS unsigned*)(KE + (8 * cg + i) * PQ + 2 * dp) = pk2(k0 * i0, k1 * i1);
              const unsigned a0 = f2bf(k0 * d0), a1 = f2bf(k1 * d1);
              if (i & 1) { kd0[i >> 1] |= a0 << 16; kd1[i >> 1] |= a1 << 16; } else { kd0[i >> 1] = a0; kd1[i >> 1] = a1; } }
          *(LAS v4u*)(KDT + (2 * dp) * PT + 8 * cg) = (v4u){kd0[0], kd0[1], kd0[2], kd0[3]};
          *(LAS v4u*)(KDT + (2 * dp + 1) * PT + 8 * cg) = (v4u){kd1[0], kd1[1], kd1[2], kd1[3]};
          if (cg == 0) { DEC[2 * dp] = __expf(tot0); DEC[2 * dp + 1] = __expf(tot1); }
          { const int c = tid >> 3, e0 = (tid & 7) * 4;
            VT[(e0 + 0) * PT + c] = (bf16)(vv.x & 0xffffu); VT[(e0 + 1) * PT + c] = (bf16)(vv.x >> 16); VT[(e0 + 2) * PT + c] = (bf16)(vv.y & 0xffffu); VT[(e0 + 3) * PT + c] = (bf16)(vv.y >> 16); } }
        LDS_WAIT(); __syncthreads();
#pragma unroll
        for (int q = 0; q < 2; ++q) { const int idx = 2 * wave + q, ti = idx >> 2, tj = idx & 3;
            f32x4 c = (f32x4){0.f, 0.f, 0.f, 0.f};
            if (tj <= ti) c = tile_mm<4>(QE, PQ, 16 * ti, KE, PQ, 16 * tj, c, l15, lq);
#pragma unroll
            for (int r = 0; r < 4; ++r) { const int cc = 16 * ti + 4 * lq + r, ss = 16 * tj + l15; ATT[cc * PT + ss] = (bf16)f2bf(ss <= cc ? c[r] : 0.f); } }
        LDS_WAIT(); __syncthreads();
        { const int tc = wave >> 1, te = wave & 1;
          f32x4 o = (f32x4){0.f, 0.f, 0.f, 0.f};
          o = tile_mm<2>(ATT, PT, 16 * tc, VT, PT, 16 * te, o, l15, lq);
          o = tile_mm<4>(QE, PQ, 16 * tc, ST, PQ, 16 * te, o, l15, lq);
#pragma unroll
          for (int r = 0; r < 4; ++r) og[(r0 + 16 * tc + 4 * lq + r) * DM + h * 256 + es * 32 + 16 * te + l15] = (bf16)f2bf(o[r]); }
        { const float dec = DEC[16 * wave + l15];
#pragma unroll
          for (int te = 0; te < 2; ++te) { f32x4 u = Sreg[te] * dec; u = tile_mm<2>(VT, PT, 16 * te, KDT, PT, 16 * wave, u, l15, lq); Sreg[te] = u; } }
        LDS_WAIT(); __syncthreads();
#pragma unroll
        for (int te = 0; te < 2; ++te)
#pragma unroll
            for (int r = 0; r < 4; ++r) ST[(16 * te + 4 * lq + r) * PQ + 16 * wave + l15] = (bf16)f2bf(Sreg[te][r]);
    }
    LDS_WAIT(); __syncthreads();
}
}

__device__ __forceinline__ void phase_kmean(const Args& a, LAS unsigned char* lds, int vcu, int G) {
    const int tid = threadIdx.x;
    const bf16* proj = (const bf16*)(a.ws + WS_PROJ); float* km = (float*)(a.ws + WS_KMEAN);
    LAS float* red = (LAS float*)(lds);
    for (int it = vcu; it < BATCH * MOBA_H * MOBA_NB; it += G) {
        const int blk = it & 7, h = (it >> 3) & 7, b = it >> 6;
        const int c2 = tid & 63, rg = tid >> 6;
        const bf16* p = proj + ((size_t)b * SEQ + blk * 256 + rg) * PP + C_MK + h * 128 + 2 * c2;
        float s0 = 0.f, s1 = 0.f;
#pragma unroll 8
        for (int r = 0; r < 32; ++r) { const unsigned w = *(const unsigned*)(p + (size_t)(8 * r) * PP); s0 += pg8::bf_lo(w); s1 += pg8::bf_hi(w); }
        red[rg * 128 + 2 * c2] = s0; red[rg * 128 + 2 * c2 + 1] = s1;
        LDS_WAIT(); __syncthreads();
        if (tid < 128) { float s = 0.f;
#pragma unroll
            for (int g = 0; g < 8; ++g) s += red[g * 128 + tid];
            km[(size_t)it * 128 + tid] = s * (1.0f / 256.0f); }
        __syncthreads();
    }
}

__device__ __forceinline__ void phase_glanorm(const Args& a, int vcu, int G) {
    const int tid = threadIdx.x, lane = tid & 63, wave = __builtin_amdgcn_readfirstlane(tid >> 6);
    const bf16* og = (const bf16*)(a.ws + WS_OG); const bf16* proj = (const bf16*)(a.ws + WS_PROJ); bf16* a1 = (bf16*)(a.ws + WS_A1);
    const float* gn = (const float*)a.in[I_GNORM] + ((16 * lane) & 255);
    float g[16];
#pragma unroll
    for (int i = 0; i < 16; ++i) g[i] = gn[i];
    const int gw = vcu * NWAVES + wave, NGW = G * NWAVES;
    for (int m = gw; m < M; m += NGW) {
        const v4u o0 = *(const v4u*)(og + (size_t)m * DM + 16 * lane), o1 = *(const v4u*)(og + (size_t)m * DM + 16 * lane + 8);
        const v4u r0 = *(const v4u*)(proj + (size_t)m * PP + C_GR + 16 * lane), r1 = *(const v4u*)(proj + (size_t)m * PP + C_GR + 16 * lane + 8);
        float v[16], r[16];
        v[0] = pg8::bf_lo(o0.x); v[1] = pg8::bf_hi(o0.x); v[2] = pg8::bf_lo(o0.y); v[3] = pg8::bf_hi(o0.y); v[4] = pg8::bf_lo(o0.z); v[5] = pg8::bf_hi(o0.z); v[6] = pg8::bf_lo(o0.w); v[7] = pg8::bf_hi(o0.w);
        v[8] = pg8::bf_lo(o1.x); v[9] = pg8::bf_hi(o1.x); v[10] = pg8::bf_lo(o1.y); v[11] = pg8::bf_hi(o1.y); v[12] = pg8::bf_lo(o1.z); v[13] = pg8::bf_hi(o1.z); v[14] = pg8::bf_lo(o1.w); v[15] = pg8::bf_hi(o1.w);
        r[0] = pg8::bf_lo(r0.x); r[1] = pg8::bf_hi(r0.x); r[2] = pg8::bf_lo(r0.y); r[3] = pg8::bf_hi(r0.y); r[4] = pg8::bf_lo(r0.z); r[5] = pg8::bf_hi(r0.z); r[6] = pg8::bf_lo(r0.w); r[7] = pg8::bf_hi(r0.w);
        r[8] = pg8::bf_lo(r1.x); r[9] = pg8::bf_hi(r1.x); r[10] = pg8::bf_lo(r1.y); r[11] = pg8::bf_hi(r1.y); r[12] = pg8::bf_lo(r1.z); r[13] = pg8::bf_hi(r1.z); r[14] = pg8::bf_lo(r1.w); r[15] = pg8::bf_hi(r1.w);
        float ss = 0.f;
#pragma unroll
        for (int i = 0; i < 16; ++i) ss = fmaf(v[i], v[i], ss);
        ss += __shfl_xor(ss, 1); ss += __shfl_xor(ss, 2); ss += __shfl_xor(ss, 4); ss += __shfl_xor(ss, 8);
        const float rs = 1.0f / sqrtf(ss * (1.0f / 256.0f) + LN_EPS);
        v4u w0, w1;
        w0.x = pk2(v[0] * rs * g[0] * r[0], v[1] * rs * g[1] * r[1]); w0.y = pk2(v[2] * rs * g[2] * r[2], v[3] * rs * g[3] * r[3]);
        w0.z = pk2(v[4] * rs * g[4] * r[4], v[5] * rs * g[5] * r[5]); w0.w = pk2(v[6] * rs * g[6] * r[6], v[7] * rs * g[7] * r[7]);
        w1.x = pk2(v[8] * rs * g[8] * r[8], v[9] * rs * g[9] * r[9]); w1.y = pk2(v[10] * rs * g[10] * r[10], v[11] * rs * g[11] * r[11]);
        w1.z = pk2(v[12] * rs * g[12] * r[12], v[13] * rs * g[13] * r[13]); w1.w = pk2(v[14] * rs * g[14] * r[14], v[15] * rs * g[15] * r[15]);
        *(v4u*)(a1 + (size_t)m * DM + 16 * lane) = w0; *(v4u*)(a1 + (size_t)m * DM + 16 * lane + 8) = w1;
    }
}

__device__ __forceinline__ void phase_ln1(const Args& a, int vcu, int G) {
    const int tid = threadIdx.x, lane = tid & 63, wave = __builtin_amdgcn_readfirstlane(tid >> 6);
    const float* pre = (const float*)(a.ws + WS_PRE1); bf16* h1b = (bf16*)(a.ws + WS_H1B);
    const f32x4* g4 = (const f32x4*)a.in[I_LN1G] + lane; const f32x4* b4 = (const f32x4*)a.in[I_LN1B] + lane;
    f32x4 gg[4], bb[4];
#pragma unroll
    for (int j = 0; j < 4; ++j) { gg[j] = g4[64 * j]; bb[j] = b4[64 * j]; }
    const int gw = vcu * NWAVES + wave, NGW = G * NWAVES;
    for (int m = gw; m < M; m += NGW) {
        const f32x4* xr = (const f32x4*)(pre + (size_t)m * DM) + lane;
        f32x4 v[4]; float s = 0.f;
#pragma unroll
        for (int j = 0; j < 4; ++j) { v[j] = xr[64 * j]; s += (v[j][0] + v[j][1]) + (v[j][2] + v[j][3]); }
        const float mean = wave_sum(s) * (1.f / DM); float s2 = 0.f;
#pragma unroll
        for (int j = 0; j < 4; ++j) { v[j] = v[j] - mean; s2 += (v[j][0] * v[j][0] + v[j][1] * v[j][1]) + (v[j][2] * v[j][2] + v[j][3] * v[j][3]); }
        const float rstd = 1.f / sqrtf(wave_sum(s2) * (1.f / DM) + LN_EPS);
        v2u* o8 = (v2u*)(h1b + (size_t)m * DM) + lane;
#pragma unroll
        for (int j = 0; j < 4; ++j) { const f32x4 y = v[j] * rstd * gg[j] + bb[j]; v2u w; w.x = pk2(y[0], y[1]); w.y = pk2(y[2], y[3]); o8[64 * j] = w; }
    }
}

__device__ __forceinline__ void phase_route(const Args& a, int vcu, int G) {
    const int tid = threadIdx.x, lane = tid & 63, wave = __builtin_amdgcn_readfirstlane(tid >> 6);
    const float* logits = (const float*)(a.ws + WS_LOGITS);
    unsigned* counts = (unsigned*)(a.ws + WS_CTL) + CW_COUNTS;
    int* list = (int*)(a.ws + WS_LIST); float* wlist = (float*)(a.ws + WS_WLIST); int* tope = (int*)(a.ws + WS_TOPE); int* topp = (int*)(a.ws + WS_TOPP);
    const f32x4 bias = *((const f32x4*)a.in[I_BR] + lane);
    const int gw = vcu * NWAVES + wave, NGW = G * NWAVES;
    const float NEG = -__builtin_inff();
    for (int t = gw; t < M; t += NGW) {
        const f32x4 lg = *((const f32x4*)(logits + (size_t)t * NEXP) + lane);
        float sc[4], bi[4];
#pragma unroll
        for (int i = 0; i < 4; ++i) { sc[i] = 1.0f / (1.0f + __expf(-lg[i])); bi[i] = sc[i] + bias[i]; }
        float m1 = fmaxf(fmaxf(bi[0], bi[1]), fmaxf(bi[2], bi[3]));
        float m2; { const float a0 = fmaxf(bi[0], bi[1]), b0 = fminf(bi[0], bi[1]), a1 = fmaxf(bi[2], bi[3]), b1 = fminf(bi[2], bi[3]); m2 = fmaxf(fminf(a0, a1), fmaxf(b0, b1)); }
#pragma unroll
        for (int o = 1; o < 8; o <<= 1) { const float o1 = __shfl_xor(m1, o), o2 = __shfl_xor(m2, o); const float n1 = fmaxf(m1, o1), n2 = fmaxf(fminf(m1, o1), fmaxf(m2, o2)); m1 = n1; m2 = n2; }
        const float gs = m1 + m2; const int grp = lane >> 3;
        int rank = 0;
#pragma unroll
        for (int g = 0; g < 8; ++g) { const float og = __shfl(gs, 8 * g); rank += (og > gs || (og == gs && g < grp)) ? 1 : 0; }
        const bool gsel = rank < TOPKG;
        float cand[4];
#pragma unroll
        for (int i = 0; i < 4; ++i) cand[i] = gsel ? bi[i] : NEG;
        int my_e = 0; float my_s = 0.f; float ssum = 0.f;
#pragma unroll 1
        for (int k = 0; k < TOPK; ++k) {
            float bv = cand[0]; int bidx = 4 * lane;
#pragma unroll
            for (int i = 1; i < 4; ++i) if (cand[i] > bv) { bv = cand[i]; bidx = 4 * lane + i; }
#pragma unroll
            for (int o = 1; o < 64; o <<= 1) { const float ov = __shfl_xor(bv, o); const int oi = __shfl_xor(bidx, o); if (ov > bv || (ov == bv && oi < bidx)) { bv = ov; bidx = oi; } }
            float s = 0.f;
#pragma unroll
            for (int i = 0; i < 4; ++i) if (bidx == 4 * lane + i) { s = sc[i]; cand[i] = NEG; }
            s = __shfl(s, bidx >> 2);
            ssum += s;
            if (lane == k) { my_e = bidx; my_s = s; }
        }
        if (lane < TOPK) {
            const float w = my_s / ssum * ROUTED_SCALE;
            const unsigned pos = atomicAdd(&counts[my_e], 1u);
            list[(size_t)my_e * M + pos] = t; wlist[(size_t)my_e * M + pos] = w;
            tope[t * TOPK + lane] = my_e; topp[t * TOPK + lane] = (int)pos;
        }
    }
}

__device__ __forceinline__ void phase_final(const Args& a, LAS unsigned char* lds, int vcu, int G) {
    const int tid = threadIdx.x, lane = tid & 63, wave = __builtin_amdgcn_readfirstlane(tid >> 6);
    const unsigned* counts = (const unsigned*)(a.ws + WS_CTL) + CW_COUNTS;
    LAS int* off = (LAS int*)(lds + TAB_OFF);
    if (tid < 256) off[tid + 1] = (int)counts[tid];
    LDS_WAIT(); __syncthreads();
    if (tid == 0) { int s = 0; off[0] = 0; for (int e = 1; e <= 256; ++e) { s += off[e]; off[e] = s; } }
    LDS_WAIT(); __syncthreads();
    const bf16* h1b = (const bf16*)(a.ws + WS_H1B); const bf16* ys = (const bf16*)(a.ws + WS_YS); const bf16* ysh = (const bf16*)(a.ws + WS_YSH); const bf16* ple = (const bf16*)(a.ws + WS_PLE);
    const int* tope = (const int*)(a.ws + WS_TOPE); const int* topp = (const int*)(a.ws + WS_TOPP);
    const f32x4* g4 = (const f32x4*)a.in[I_LN2G] + lane; const f32x4* b4 = (const f32x4*)a.in[I_LN2B] + lane;
    f32x4 gg[4], bb[4];
#pragma unroll
    for (int j = 0; j < 4; ++j) { gg[j] = g4[64 * j]; bb[j] = b4[64 * j]; }
    const int gw = vcu * NWAVES + wave, NGW = G * NWAVES;
    for (int m = gw; m < M; m += NGW) {
        int row = 0; if (lane < TOPK) row = off[tope[m * TOPK + lane]] + topp[m * TOPK + lane];
        f32x4 v[4];
#pragma unroll
        for (int j = 0; j < 4; ++j) { const v2u h = *((const v2u*)(h1b + (size_t)m * DM) + lane + 64 * j), s = *((const v2u*)(ysh + (size_t)m * DM) + lane + 64 * j), p = *((const v2u*)(ple + (size_t)m * DM) + lane + 64 * j);
            v[j][0] = ALPHA * pg8::bf_lo(h.x) + pg8::bf_lo(s.x) + pg8::bf_lo(p.x); v[j][1] = ALPHA * pg8::bf_hi(h.x) + pg8::bf_hi(s.x) + pg8::bf_hi(p.x);
            v[j][2] = ALPHA * pg8::bf_lo(h.y) + pg8::bf_lo(s.y) + pg8::bf_lo(p.y); v[j][3] = ALPHA * pg8::bf_hi(h.y) + pg8::bf_hi(s.y) + pg8::bf_hi(p.y); }
#pragma unroll
        for (int k = 0; k < TOPK; ++k) { const int rk = __shfl(row, k); const v2u* yr = (const v2u*)(ys + (size_t)rk * DM) + lane;
#pragma unroll
            for (int j = 0; j < 4; ++j) { const v2u y = yr[64 * j]; v[j][0] += pg8::bf_lo(y.x); v[j][1] += pg8::bf_hi(y.x); v[j][2] += pg8::bf_lo(y.y); v[j][3] += pg8::bf_hi(y.y); } }
        float s = 0.f;
#pragma unroll
        for (int j = 0; j < 4; ++j) s += (v[j][0] + v[j][1]) + (v[j][2] + v[j][3]);
        const float mean = wave_sum(s) * (1.f / DM); float s2 = 0.f;
#pragma unroll
        for (int j = 0; j < 4; ++j) { v[j] = v[j] - mean; s2 += (v[j][0] * v[j][0] + v[j][1] * v[j][1]) + (v[j][2] * v[j][2] + v[j][3] * v[j][3]); }
        const float rstd = 1.f / sqrtf(wave_sum(s2) * (1.f / DM) + LN_EPS);
        f32x4* o = (f32x4*)(a.out + (size_t)m * DM) + lane;
#pragma unroll
        for (int j = 0; j < 4; ++j) o[64 * j] = v[j] * rstd * gg[j] + bb[j];
    }
}

constexpr int MAXT = 8;
constexpr int T_CNT = TAB_OFF, T_OFF = T_CNT + 1024, T_SUS = T_OFF + 1040, T_REC = T_SUS + 1040, T_ROWS = T_REC + 4 * MAXT * 4, T_END = T_ROWS + MAXT * 256 * 4;
static_assert(T_END <= LDS_BYTES, "tables fit above the ring");
struct ExpSched1 {
    LAS const int* rec; LAS const int* rows; int nt; const unsigned char* h1b; const unsigned char* we1;
    __device__ bool next(int i, pg8::Unit& u) const { if (i >= 2 * nt) return false; const int k = i >> 1; u.pm = k; u.pn = i & 1; u.aux = rec[2 * MAXT + k]; u.aux2 = rec[3 * MAXT + k]; u.aux3 = 0; return true; }
    __device__ __forceinline__ const char* a_base(const pg8::Unit&) const { return (const char*)h1b; }
    __device__ __forceinline__ const char* b_base(const pg8::Unit& u) const { return (const char*)we1 + ((size_t)rec[u.pm] * 512 + u.pn * 256) * 1024 * 2; }
    __device__ __forceinline__ unsigned a_off(int pm, int r, int c) const { return ((unsigned)rows[pm * 256 + r] * 1024u + (unsigned)c) * 2u; }
};
struct ExpSched2 {
    LAS const int* rec; int nt; const unsigned char* hexp; const unsigned char* we2;
    __device__ bool next(int i, pg8::Unit& u) const { if (i >= 4 * nt) return false; const int k = i >> 2; u.pm = k; u.pn = i & 3; u.aux = rec[2 * MAXT + k]; u.aux2 = rec[3 * MAXT + k]; u.aux3 = rec[k] * M + rec[MAXT + k] * 256; return true; }
    __device__ __forceinline__ const char* a_base(const pg8::Unit& u) const { return (const char*)hexp + (size_t)u.aux2 * DEXP * 2; }
    __device__ __forceinline__ const char* b_base(const pg8::Unit& u) const { return (const char*)we2 + ((size_t)rec[u.pm] * 1024 + u.pn * 256) * 256 * 2; }
    __device__ __forceinline__ unsigned a_off(int, int, int) const { return 0u; }
};

__global__ void __launch_bounds__(NWAVES * 64, 2) mk_fwd(Args args) {
    extern __shared__ __attribute__((aligned(16))) unsigned char lds_raw[];
    LAS unsigned char* lds = (LAS unsigned char*)lds_raw;
    volatile LAS unsigned* MISC = (volatile LAS unsigned*)(lds + MISC_OFF);
    const int tid = threadIdx.x;
    const int G = gridDim.x; const int bx = blockIdx.x; const int vcu = (G % 8 == 0) ? (bx % 8) * (G / 8) + bx / 8 : bx;
    unsigned char* ws = args.ws;
    gu32* ctl = (gu32*)(ws + WS_CTL);
    for (int u = tid; u < (LDS_BYTES - LDSCTL_OFF) / 4; u += NWAVES * 64) ((LAS unsigned*)(lds + LDSCTL_OFF))[u] = 0u;
    __syncthreads();
    const int lo = args.ph_lo, hi = args.ph_hi;
    const bool one_launch = (hi - lo) > 1;
    XcdBarrier bar; bar.bar = (unsigned*)(ctl + CW_BAR); bar.x = 0; bar.st = nullptr;
    if (one_launch) bar = xcd_barrier_post((unsigned*)(ctl + CW_BAR), MISC + 8);
#ifndef PHASE_MASK
#define PHASE_MASK 0xFFF
#endif
#define IN(k) (((PHASE_MASK >> (k)) & 1) && lo <= (k) && (k) < hi)
#define SEAM(k) do { if (IN(k) && IN((k) + 1)) xcd_barrier(bar); } while (0)

    if (IN(0)) { phase0(args, lds, vcu, G); } SEAM(0);

    if (IN(1)) {
        { pg8::StaticOrder S; S.init((const bf16*)(ws + WS_XB), (const bf16*)(ws + WS_WIN), M, NPROJ, DM, G, bx);
          epi::EpiProj E{(bf16*)(ws + WS_PROJ), (float*)(ws + WS_LOW), (const float*)(ws + WS_CS)};
          pg8::gemm_phase<epi::EpiProj, pg8::StaticOrder, true, true, false>(lds + RING_OFF, DM, S, E); }
        { pg8::StaticOrder S; S.init((const bf16*)(ws + WS_PB), (const bf16*)(ws + WS_WP), M, DM, PLE_DIM, G, bx);
          epi::EpiBf16<false> E{(bf16*)(ws + WS_PW), DM};
          pg8::gemm_phase<epi::EpiBf16<false>, pg8::StaticOrder, true, true, false>(lds + RING_OFF, PLE_DIM, S, E); }
    } SEAM(1);

    if (IN(2)) { phase_kmean(args, lds, vcu, G); } SEAM(2);

    if (IN(3)) {
        for (int L = bx; L < 256; L += G) {
            const int xcd = L & 7, k = L >> 3, bh = (k >> 2) * 8 + xcd, x = k & 3, b = bh >> 3, h = bh & 7;
            const bf16* proj = (const bf16*)(ws + WS_PROJ) + (size_t)b * SEQ * PP + h * 128; bf16* om = (bf16*)(ws + WS_OM) + (size_t)b * SEQ * DM + h * 128;
            const float* km = (const float*)(ws + WS_KMEAN) + (size_t)bh * MOBA_NB * 128;
            moba::BlockRef cur{proj + C_MQ + (size_t)(x * 256) * PP, proj + C_MK, proj + C_MV, om + (size_t)(x * 256) * DM, km, x * 256};
            const bf16* q1 = proj + C_MQ + (size_t)((7 - x) * 256) * PP;
            moba::Seam S;
            moba::prime(cur, (char*)lds_raw, S);
#pragma unroll 1
            for (int pass = 0; pass < 2; ++pass) { moba::block(cur, q1, (char*)lds_raw, S); cur.Q = q1; cur.O = om + (size_t)((7 - x) * 256) * DM; cur.P0 = (7 - x) * 256; }
            VM_WAIT(); __syncthreads();
        }
        for (int L = bx; L < 256; L += G) {
            const int xcd = L & 7, k = L >> 3, bh = (k >> 3) * 8 + xcd, es = k & 7;
            gla::item(args, lds, bh >> 2, bh & 3, es);
        }
    } SEAM(3);

    if (IN(4)) { phase_glanorm(args, vcu, G); } SEAM(4);

    if (IN(5)) {
        { pg8::StaticOrder S; S.init((const bf16*)(ws + WS_A1), (const bf16*)(ws + WS_WGO), M, DM, DM, G, bx);
          epi::EpiGate<false> E{(bf16*)(ws + WS_MERGED), (const bf16*)(ws + WS_PROJ) + C_GA};
          pg8::gemm_phase<epi::EpiGate<false>, pg8::StaticOrder, true, true, false>(lds + RING_OFF, DM, S, E); }
        { pg8::StaticOrder S; S.init((const bf16*)(ws + WS_OM), (const bf16*)(ws + WS_WMO), M, DM, DM, G, bx);
          epi::EpiGate<true> E{(bf16*)(ws + WS_MERGED), (const bf16*)(ws + WS_PROJ) + C_GB};
          pg8::gemm_phase<epi::EpiGate<true>, pg8::StaticOrder, true, true, false>(lds + RING_OFF, DM, S, E); }
    } SEAM(5);

    if (IN(6)) {
        pg8::StaticOrder S; S.init((const bf16*)(ws + WS_MERGED), (const bf16*)(ws + WS_WOUT), M, DM, DM, G, bx);
        epi::EpiPre1 E{(const float*)args.in[I_X], (float*)(ws + WS_PRE1)};
        pg8::gemm_phase<epi::EpiPre1, pg8::StaticOrder, true, true, false>(lds + RING_OFF, DM, S, E);
    } SEAM(6);

    if (IN(7)) { phase_ln1(args, vcu, G); } SEAM(7);

    if (IN(8)) {
        { pg8::StaticOrder S; S.init((const bf16*)(ws + WS_H1B), (const bf16*)(ws + WS_WR), M, NEXP, DM, G, bx);
          epi::EpiF32 E{(float*)(ws + WS_LOGITS), NEXP};
          pg8::gemm_phase<epi::EpiF32, pg8::StaticOrder, true, true, false>(lds + RING_OFF, DM, S, E); }
        { pg8::StaticOrder S; S.init((const bf16*)(ws + WS_H1B), (const bf16*)(ws + WS_WS1), M, 512, DM, G, (bx + 192) % G);
          epi::EpiSwiGLU E{(bf16*)(ws + WS_HSH)};
          pg8::gemm_phase<epi::EpiSwiGLU, pg8::StaticOrder, true, true, false>(lds + RING_OFF, DM, S, E); }
        { pg8::StaticOrder S; S.init((const bf16*)(ws + WS_H1B), (const bf16*)(ws + WS_WPG), M, DM, DM, G, bx);
          epi::EpiPle E{(const bf16*)(ws + WS_PW), (bf16*)(ws + WS_PLE)};
          pg8::gemm_phase<epi::EpiPle, pg8::StaticOrder, true, true, false>(lds + RING_OFF, DM, S, E); }
    } SEAM(8);

    if (IN(9)) { phase_route(args, vcu, G); } SEAM(9);

    if (IN(10)) {
        LAS int* cnt = (LAS int*)(lds + T_CNT); LAS int* off = (LAS int*)(lds + T_OFF); LAS int* sus = (LAS int*)(lds + T_SUS); LAS int* rec = (LAS int*)(lds + T_REC); LAS int* rows = (LAS int*)(lds + T_ROWS);
        const unsigned* counts = (const unsigned*)(ws + WS_CTL) + CW_COUNTS;
        if (tid < 256) cnt[tid] = (int)counts[tid];
        LDS_WAIT(); __syncthreads();
        if (tid == 0) { int s = 0, t = 0; for (int e = 0; e < 256; ++e) { off[e] = s; sus[e] = t; s += cnt[e]; t += (cnt[e] + 255) >> 8; } off[256] = s; sus[256] = t; }
        LDS_WAIT(); __syncthreads();
        const int nsu = sus[256];
        for (int base = bx; base < nsu; base += G * MAXT) {
            int nt = 0;
            for (int k = 0; k < MAXT; ++k) { const int su = base + k * G; if (su < nsu) nt = k + 1; }
            if (tid < nt) { const int su = base + tid * G; int lo_ = 0, hi_ = 255;
                while (lo_ < hi_) { const int mid = (lo_ + hi_ + 1) >> 1; if (sus[mid] <= su) lo_ = mid; else hi_ = mid - 1; }
                const int e = lo_;
                const int mt = su - sus[e];
                rec[tid] = e; rec[MAXT + tid] = mt; const int valid = cnt[e] - mt * 256; rec[2 * MAXT + tid] = valid > 256 ? 256 : valid; rec[3 * MAXT + tid] = off[e] + mt * 256; }
            LDS_WAIT(); __syncthreads();
            { const int* list = (const int*)(ws + WS_LIST);
              for (int i = tid; i < nt * 256; i += NWAVES * 64) { const int k = i >> 8, r = i & 255; rows[i] = (r < rec[2 * MAXT + k]) ? list[(size_t)rec[k] * M + rec[MAXT + k] * 256 + r] : 0; } }
            LDS_WAIT(); __syncthreads();
            { ExpSched1 S{rec, rows, nt, ws + WS_H1B, ws + WS_WE1};
              epi::EpiSwiGLU E{(bf16*)(ws + WS_HEXP)};
              pg8::gemm_phase<epi::EpiSwiGLU, ExpSched1, true, true, true>(lds + RING_OFF, DM, S, E); }
            VM_WAIT(); __syncthreads();
            { ExpSched2 S{rec, nt, ws + WS_HEXP, ws + WS_WE2};
              epi::EpiDown E{(bf16*)(ws + WS_YS), (const float*)(ws + WS_WLIST)};
              pg8::gemm_phase<epi::EpiDown, ExpSched2, true, true, false>(lds + RING_OFF, DEXP, S, E); }
            __syncthreads();
        }
        { pg8::StaticOrder S; S.init((const bf16*)(ws + WS_HSH), (const bf16*)(ws + WS_WS2), M, DM, DEXP, G, bx);
          epi::EpiDown E{(bf16*)(ws + WS_YSH), nullptr};
          pg8::gemm_phase<epi::EpiDown, pg8::StaticOrder, true, true, false>(lds + RING_OFF, DEXP, S, E); }
    } SEAM(10);

    if (IN(11)) { phase_final(args, lds, vcu, G); }
#undef IN
#undef SEAM
}

constexpr int NPHASES = 12;
#ifndef MK_N_LAUNCHES
#define MK_N_LAUNCHES 1
#endif

extern "C" void kernel_launch(void* const* d_in, const int* in_sizes, int n_in, void* d_out, int out_size, void* d_ws, size_t ws_size, hipStream_t stream) {
    static int grid = 0;
    if (grid == 0) {
        if (n_in != 24 || in_sizes[0] != M * DM || out_size != M * DM || ws_size < WS_END) { fprintf(stderr, "kernel_launch: unexpected shapes (n_in %d, in0 %d, out %d, ws %zu < %zu)\n", n_in, n_in > 0 ? in_sizes[0] : -1, out_size, ws_size, (size_t)WS_END); grid = -1; return; }
        int dev = 0, cus = 0;
        if (hipGetDevice(&dev) != hipSuccess || hipDeviceGetAttribute(&cus, hipDeviceAttributeMultiprocessorCount, dev) != hipSuccess) { grid = -1; return; }
        if (hipFuncSetAttribute((const void*)mk_fwd, hipFuncAttributeMaxDynamicSharedMemorySize, LDS_BYTES) != hipSuccess) { fprintf(stderr, "kernel_launch: hipFuncSetAttribute failed\n"); grid = -1; return; }
        int per_cu = 0;
        if (hipOccupancyMaxActiveBlocksPerMultiprocessor(&per_cu, (const void*)mk_fwd, NWAVES * 64, LDS_BYTES) != hipSuccess || per_cu < 1) fprintf(stderr, "kernel_launch: occupancy query reports %d per CU\n", per_cu);
        (void)hipGetLastError();
        grid = cus;
    }
    if (grid < 0) return;
    if (hipMemsetAsync((char*)d_ws + WS_CTL, 0, CTL_ZERO_BYTES, stream) != hipSuccess) { fprintf(stderr, "kernel_launch: memset failed\n"); return; }
    Args a{};
    for (int i = 0; i < 24; ++i) a.in[i] = d_in[i];
    a.out = (float*)d_out; a.ws = (unsigned char*)d_ws;
    if (MK_N_LAUNCHES == 1) { a.ph_lo = 0; a.ph_hi = NPHASES; hipLaunchKernelGGL(mk_fwd, dim3(grid), dim3(NWAVES * 64), LDS_BYTES, stream, a); }
    else { for (int p = 0; p < NPHASES; ++p) { a.ph_lo = p; a.ph_hi = p + 1; hipLaunchKernelGGL(mk_fwd, dim3(grid), dim3(NWAVES * 64), LDS_BYTES, stream, a); } }
    const hipError_t le = hipPeekAtLastError();
    if (le != hipSuccess) fprintf(stderr, "kernel_launch: launch failed: %s\n", hipGetErrorName(le));
}
```

```cpp
#include <hip/hip_runtime.h>
#include <cstdio>
#include <cstdint>
#include <cmath>
#ifndef MK_N_LAUNCHES
#define MK_N_LAUNCHES 1
#endif
constexpr int NWAVES = 8;
constexpr int BATCH = 8, SEQ = 2048, DM = 1024, M = BATCH * SEQ;
constexpr int GLA_H = 4, GLA_DK = 128, GLA_DV = 256, GLA_RANK = 16, GLA_CHUNK = 64;
constexpr int MOBA_H = 8, MOBA_DH = 128, MOBA_BLK = 256, MOBA_NB = SEQ / MOBA_BLK;
constexpr int NEXP = 256, TOPK = 8, NGRP = 8, TOPKG = 4, DEXP = 256, PLE_DIM = 256;
constexpr int IN_COLS = 8208, NPROJ = 8448;
constexpr int PP = 8192;
constexpr int C_GQ = 0, C_GK = 512, C_GV = 1024, C_GR = 2048, C_MQ = 3072, C_MK = 4096, C_MV = 5120, C_GA = 6144, C_GB = 7168;
constexpr float LN_EPS = 1e-5f;
constexpr float ALPHA = 1.189207115002721f;
constexpr float ROUTED_SCALE = 2.5f;

constexpr size_t MiB = 1u << 20;
constexpr size_t WS_CTL = 0, CTL_ZERO_BYTES = 1 * MiB;
constexpr size_t WS_CS = 1 * MiB;
constexpr size_t WS_LOW = 3 * MiB;
constexpr size_t WS_KMEAN = 4 * MiB;
constexpr size_t WS_TOPE = 5 * MiB;
constexpr size_t WS_TOPP = 5 * MiB + 512 * 1024;
constexpr size_t WS_WR = 8 * MiB, WS_WP = 8 * MiB + 512 * 1024, WS_WS1 = 9 * MiB, WS_WS2 = 10 * MiB;
constexpr size_t WS_WGO = 12 * MiB, WS_WMO = 14 * MiB, WS_WOUT = 16 * MiB, WS_WPG = 18 * MiB;
constexpr size_t WS_WIN = 20 * MiB;
constexpr size_t WS_LIST = 38 * MiB;
constexpr size_t WS_WLIST = 54 * MiB;
constexpr size_t WS_LOGITS = 70 * MiB;
constexpr size_t WS_GQE = 38 * MiB, WS_GKDT = 54 * MiB, WS_GATT = 70 * MiB, WS_GDEC = 78 * MiB;
constexpr size_t WS_XB = 86 * MiB;
constexpr size_t WS_PB = 118 * MiB;
constexpr size_t WS_PW = 126 * MiB;
constexpr size_t WS_H1B = 158 * MiB;
constexpr size_t WS_WE1 = 190 * MiB;
constexpr size_t WS_WE2 = 446 * MiB;
constexpr size_t WS_R1 = 574 * MiB;
constexpr size_t WS_PROJ = WS_R1, WS_PRE1 = WS_R1, WS_YS = WS_R1;
constexpr size_t WS_R2 = 832 * MiB;
constexpr size_t WS_OG = WS_R2, WS_A1 = WS_R2 + 32 * MiB, WS_OM = WS_R2 + 64 * MiB, WS_MERGED = WS_R2 + 96 * MiB;
constexpr size_t WS_HEXP = WS_R2, WS_YSH = WS_R2 + 66 * MiB, WS_HSH = WS_R2 + 98 * MiB, WS_PLE = WS_R2 + 106 * MiB;
constexpr size_t WS_END = WS_R2 + 138 * MiB;
static_assert(WS_YS + (size_t)(M * TOPK + 256) * DM * 2 <= WS_R2, "YS fits R1");
static_assert(WS_END <= 1024 * MiB, "ws budget");
constexpr int CW_COUNTS = 1024;
constexpr int CW_DBG = 2048;
constexpr int CW_BAR = 4096;

constexpr int RING_OFF = 0, RING_BYTES = 131072;
constexpr int LDSCTL_OFF = RING_BYTES, MISC_OFF = LDSCTL_OFF + 320;
constexpr int TAB_OFF = RING_BYTES + 1024;
constexpr int LDS_BYTES = 147456;

#define GAS __attribute__((address_space(1)))
#define LAS __attribute__((address_space(3)))
typedef unsigned short bf16;
typedef unsigned v4u __attribute__((ext_vector_type(4)));
typedef unsigned v2u __attribute__((ext_vector_type(2)));
typedef float f32x4 __attribute__((ext_vector_type(4)));
typedef short bf16x8 __attribute__((ext_vector_type(8)));
typedef GAS unsigned gu32;
#define RLX_AGENT __ATOMIC_RELAXED, __HIP_MEMORY_SCOPE_AGENT
#define LDS_WAIT() asm volatile("s_waitcnt lgkmcnt(0)" ::: "memory")
#define VM_WAIT() asm volatile("s_waitcnt vmcnt(0)" ::: "memory")
__device__ __forceinline__ unsigned f2bf(float f) { unsigned u = __builtin_bit_cast(unsigned, f); return (u + 0x7fffu + ((u >> 16) & 1u)) >> 16; }
__device__ __forceinline__ unsigned pk2(float lo, float hi) { return f2bf(lo) | (f2bf(hi) << 16); }
__device__ __forceinline__ float bf2f(unsigned short h) { return __uint_as_float(((unsigned)h) << 16); }

#define XB_TMO      128
#define XB_XCNT(j)  (256  + 64 * (j))
#define XB_XSUB(j)  (1280 + 64 * (j))
#define XB_XGEN(j)  (2304 + 64 * (j))
#define XB_TOP      3328
#define XB_TOPGEN   3392
#define XCD_BAR_WORDS 3456
#define XB_SPIN_CAP (1u << 18)
__device__ __forceinline__ unsigned xb_ld(unsigned* p)              { return __hip_atomic_load(p, __ATOMIC_RELAXED, __HIP_MEMORY_SCOPE_AGENT); }
__device__ __forceinline__ unsigned xb_add(unsigned* p, unsigned v) { return __hip_atomic_fetch_add(p, v, __ATOMIC_RELAXED, __HIP_MEMORY_SCOPE_AGENT); }
__device__ __forceinline__ unsigned xb_xcc_id() { return (unsigned)__builtin_amdgcn_s_getreg((3 << 11) | 20) & 0xFu; }
#define XB_SPIN(cond, bar) do { unsigned _sp = 0; while (cond) { __builtin_amdgcn_s_sleep(1); \
    if ((++_sp & 255u) == 0u) { if (xb_ld(&(bar)[XB_TMO])) break; if (_sp > XB_SPIN_CAP) { atomicAdd(&(bar)[XB_TMO], 1u); break; } } } } while (0)
struct XcdBarrier { unsigned* bar; unsigned x; volatile LAS unsigned* st; };
__device__ __forceinline__ XcdBarrier xcd_barrier_post(unsigned* bar, volatile LAS unsigned* st) {
    XcdBarrier b; b.bar = bar; b.x = xb_xcc_id(); b.st = st;
    if (threadIdx.x == 0) (void)xb_add(&bar[XB_XCNT(b.x)], 1u);
    return b;
}
__device__ __forceinline__ void xcd_barrier_complete(unsigned* bar, unsigned x, unsigned& nloc, unsigned& nx) {
    const unsigned G = gridDim.x * gridDim.y * gridDim.z;
    unsigned sum, cnt, mine, sp = 0u;
    for (;;) {
        sum = 0u; cnt = 0u; mine = 0u;
#pragma unroll
        for (unsigned j = 0; j < 16; ++j) { const unsigned c = xb_ld(&bar[XB_XCNT(j)]); sum += c; cnt += (c > 0u) ? 1u : 0u; mine = (j == x) ? c : mine; }
        if (sum == G) break;
        __builtin_amdgcn_s_sleep(1);
        if ((++sp & 255u) == 0u) { if (xb_ld(&bar[XB_TMO])) break; if (sp > XB_SPIN_CAP) { atomicAdd(&bar[XB_TMO], 1u); break; } }
    }
    nloc = mine > 0u ? mine : 1u; nx = cnt > 0u ? cnt : 1u;
}
__device__ __forceinline__ void xcd_barrier(const XcdBarrier& b) {
    asm volatile("s_waitcnt vmcnt(0)" ::: "memory");
    __syncthreads();
    if (threadIdx.x == 0) {
        unsigned* bar = b.bar;
        __builtin_amdgcn_s_waitcnt(0);
        unsigned nloc = b.st[0], nx = b.st[1];
        if (nloc == 0u) { xcd_barrier_complete(bar, b.x, nloc, nx); b.st[0] = nloc; b.st[1] = nx; }
        const unsigned old = xb_add(&bar[XB_XSUB(b.x)], 1u);
        const unsigned gen = old / nloc;
        if (old + 1u == (gen + 1u) * nloc) {
            __builtin_amdgcn_fence(__ATOMIC_RELEASE, "agent");
            asm volatile("s_waitcnt vmcnt(0)" ::: "memory");
            const unsigned og = xb_add(&bar[XB_TOP], 1u);
            const unsigned tg = og / nx;
            if (og + 1u == (tg + 1u) * nx) xb_add(&bar[XB_TOPGEN], 1u);
            else XB_SPIN(xb_ld(&bar[XB_TOPGEN]) == tg, bar);
            __builtin_amdgcn_fence(__ATOMIC_ACQUIRE, "agent");
            xb_add(&bar[XB_XGEN(b.x)], 1u);
            asm volatile("s_waitcnt vmcnt(0)" ::: "memory");
        } else {
            XB_SPIN(xb_ld(&bar[XB_XGEN(b.x)]) == gen, bar);
            __builtin_amdgcn_fence(__ATOMIC_ACQUIRE, "agent");
            asm volatile("s_waitcnt vmcnt(0)" ::: "memory");
        }
    }
    __syncthreads();
}

__device__ __forceinline__ float wave_sum(float v) {
#pragma unroll
    for (int o = 1; o < 64; o <<= 1) v += __shfl_xor(v, o);
    return v;
}

namespace pg8 {
#define PG8_LAS __attribute__((address_space(3)))
typedef unsigned short bf16_t;
typedef short bf16x8 __attribute__((ext_vector_type(8)));
typedef float f32x4 __attribute__((ext_vector_type(4)));
typedef float f32x2 __attribute__((ext_vector_type(2)));
typedef unsigned u32x4 __attribute__((ext_vector_type(4)));
typedef unsigned u32x2 __attribute__((ext_vector_type(2)));
constexpr int BM = 256, BK = 64, HALF = 128, HTB = HALF * BK * 2  , STAGE_BYTES = 8 * HTB, NXCD = 8, WGM = 8;

__host__ __device__ __forceinline__ int lds_byte(int r, int c) { const int st = (r >> 4) * 2 + (c >> 5), rr = r & 15, cc = c & 31, ob = rr * 64 + cc * 2; return st * 1024 + (ob ^ (((ob >> 9) & 1) << 5)); }
__host__ __device__ __forceinline__ void stage_rc(int b, int& R, int& C) { const int st = b / 1024, sb = b % 1024, swz = sb ^ (((sb >> 9) & 1) << 5); R = (st >> 1) * 16 + swz / 64; C = (st & 1) * 32 + (swz % 64) / 2; }
__host__ __device__ __forceinline__ int perm32(int rho) { const int n = rho >> 4, i = rho & 15; return 8 * (i >> 2) + 4 * n + (i & 3); }

struct Unit { int pm, pn, aux, aux2, aux3; };

struct StaticOrder {
    static constexpr bool PARTIAL = false;
    const bf16_t* A; const bf16_t* Bt; int K;
    int nM, nN, nwg, G, c;
    __device__ void init(const bf16_t* A_, const bf16_t* Bt_, int M, int N, int K_, int G_, int c_) { A = A_; Bt = Bt_; K = K_; nM = M / BM; nN = N / BM; nwg = nM * nN; G = G_; c = c_; }
    __device__ bool next(int i, Unit& u) const {
        const long L = (long)i * G + c; if (L >= nwg) return false;
        int wgid = (int)L; { const int q = nwg / NXCD, r = nwg % NXCD, xcd = wgid % NXCD, off = wgid / NXCD; wgid = (xcd < r ? xcd * (q + 1) : r * (q + 1) + (xcd - r) * q) + off; }
        const int nig = WGM * nN, gid = wgid / nig, fm = gid * WGM, gsz = (nM - fm) < WGM ? (nM - fm) : WGM;
        u.pm = fm + ((wgid % nig) % gsz); u.pn = (wgid % nig) / gsz; u.aux = 256; u.aux2 = u.pm * 256; u.aux3 = 0; return true;
    }
    __device__ __forceinline__ const char* a_base(const Unit& u) const { return (const char*)A + (size_t)u.pm * 256 * K * 2; }
    __device__ __forceinline__ const char* b_base(const Unit& u) const { return (const char*)Bt + (size_t)u.pn * 256 * K * 2; }
    __device__ __forceinline__ unsigned a_off(int, int, int) const { return 0u; }
};

__device__ __forceinline__ unsigned cvt_pk_bf16(float lo, float hi) { unsigned r; asm volatile("v_cvt_pk_bf16_f32 %0, %1, %2" : "=v"(r) : "v"(lo), "v"(hi)); return r; }
__device__ __forceinline__ float bf_lo(unsigned w) { return __uint_as_float(w << 16); }
__device__ __forceinline__ float bf_hi(unsigned w) { return __uint_as_float(w & 0xffff0000u); }
__device__ __forceinline__ float sigmoidf_(float x) { return __builtin_amdgcn_rcpf(1.0f + __builtin_amdgcn_exp2f(-1.4426950408889634f * x)); }
__device__ __forceinline__ float siluf_(float x) { return x * sigmoidf_(x); }

template <class Epi, class Sched, bool ALIGN_EPI = false, bool SP2 = false, bool GA = false>
__device__ __forceinline__ void gemm_phase(PG8_LAS unsigned char* lds, const int K, const Sched& S, const Epi& E) {
    const int tid = threadIdx.x, wid = __builtin_amdgcn_readfirstlane(tid >> 6), lane = tid & 63, wr = wid >> 2, wc = wid & 3, fr = lane & 15, fq = lane >> 4;
    const int nt = K / BK;
    unsigned voffA[2], voffB[2];
#pragma unroll
    for (int i = 0; i < 2; ++i) { int R, C; stage_rc(tid * 16 + i * 8192, R, C); const int Rb = Epi::PERM ? ((R & ~31) + perm32(R & 31)) : R;
        voffA[i] = (unsigned)(R * K + C) * 2u; voffB[i] = (unsigned)(Rb * K + C) * 2u; }
    const size_t kstep = (size_t)(BK * 2);
    const size_t hstep = (size_t)HALF * K * 2;
    const size_t hstepA = GA ? 0 : hstep;
    const unsigned ldsw = (unsigned)wid * 1024u;
    const int aoff = lds_byte(wr * 64 + fr, fq * 8), boff = lds_byte(wc * 32 + fr, fq * 8);
#define PG8_SA(b, h) (((b) * 2 + (h)) * HTB)
#define PG8_SB(b, h) ((4 + (b) * 2 + (h)) * HTB)
#define PG8_STAGE(bufoff, gbase, voff) do { _Pragma("unroll") for (int _i = 0; _i < 2; ++_i) \
        __builtin_amdgcn_global_load_lds((const unsigned*)((const char*)(gbase) + (voff)[_i]), (PG8_LAS unsigned*)(lds + (bufoff) + ldsw + _i * 8192), 16, 0, 0); } while (0)
#define PG8_LDA(dst, b, h) do { _Pragma("unroll") for (int m = 0; m < 4; ++m) _Pragma("unroll") for (int k = 0; k < 2; ++k) dst[m][k] = *(const PG8_LAS bf16x8*)(lds + PG8_SA(b, h) + aoff + m * 2048 + k * 1024); } while (0)
#define PG8_LDB(dst, b, h) do { _Pragma("unroll") for (int n = 0; n < 2; ++n) _Pragma("unroll") for (int k = 0; k < 2; ++k) dst[n][k] = *(const PG8_LAS bf16x8*)(lds + PG8_SB(b, h) + boff + n * 2048 + k * 1024); } while (0)
#define PG8_MMA(ai, bj, At, Bt) do { if (!Sched::PARTIAL || (ai == 0 ? do0 : do1)) { __builtin_amdgcn_s_setprio(1); _Pragma("unroll") for (int m = 0; m < 4; ++m) _Pragma("unroll") for (int n = 0; n < 2; ++n) _Pragma("unroll") for (int k = 0; k < 2; ++k) \
        acc[ai][bj][m][n] = __builtin_amdgcn_mfma_f32_16x16x32_bf16(Bt[n][k], At[m][k], acc[ai][bj][m][n], 0, 0, 0); __builtin_amdgcn_s_setprio(0); } } while (0)
#define PG8_WAIT_V(n) asm volatile("s_waitcnt vmcnt(" #n ")" ::: "memory")
#define PG8_WAIT_L(n) asm volatile("s_waitcnt lgkmcnt(" #n ")" ::: "memory")
#define PG8_BAR __builtin_amdgcn_s_barrier()
#define PG8_SCHED __builtin_amdgcn_sched_barrier(0)
    Unit cur, nxt; int ui = 0;
    if (!S.next(0, cur)) return;
    f32x4 acc[2][2][4][2];
#pragma unroll
    for (int a = 0; a < 2; ++a)
#pragma unroll
        for (int b = 0; b < 2; ++b)
#pragma unroll
            for (int m = 0; m < 4; ++m)
#pragma unroll
                for (int n = 0; n < 2; ++n) acc[a][b][m][n] = (f32x4){0.f, 0.f, 0.f, 0.f};
    bf16x8 At[4][2], B0[2][2], B1[2][2];
    const char* cA = S.a_base(cur); const char* cB = S.b_base(cur);
#define PG8_STAGE_A(bufoff, gbase, h, NX) do { if constexpr (GA) { int t_ = (int)__builtin_amdgcn_mbcnt_hi(~0u, __builtin_amdgcn_mbcnt_lo(~0u, 0u)); asm volatile("" : "+v"(t_)); t_ += wid * 64; \
        const int pmx_ = (NX) ? nxt.pm : cur.pm; unsigned vg_[2]; _Pragma("unroll") for (int _j = 0; _j < 2; ++_j) { int R_, C_; stage_rc(t_ * 16 + _j * 8192, R_, C_); vg_[_j] = S.a_off(pmx_, (h) * HALF + R_, C_); } PG8_STAGE(bufoff, gbase, vg_); } \
        else { PG8_STAGE(bufoff, (gbase) + (h) * hstep, voffA); } } while (0)
    if constexpr (SP2) {
        PG8_STAGE(PG8_SB(0, 0), cB, voffB); PG8_STAGE(PG8_SB(0, 1), cB + hstep, voffB); PG8_STAGE_A(PG8_SA(0, 0), cA, 0, false); PG8_STAGE_A(PG8_SA(0, 1), cA, 1, false);
        if (wr == 1) PG8_BAR;
        PG8_WAIT_V(2); PG8_BAR;
        PG8_STAGE(PG8_SB(1, 0), cB + kstep, voffB); PG8_STAGE_A(PG8_SA(1, 0), cA + kstep, 0, false); PG8_STAGE(PG8_SB(1, 1), cB + hstep + kstep, voffB);
        PG8_WAIT_V(6); PG8_BAR;
    } else {
        PG8_STAGE(PG8_SB(0, 0), cB, voffB); PG8_STAGE_A(PG8_SA(0, 0), cA, 0, false); PG8_STAGE(PG8_SB(0, 1), cB + hstep, voffB); PG8_STAGE_A(PG8_SA(0, 1), cA, 1, false);
        if (wr == 1) PG8_BAR;
        PG8_WAIT_V(4); PG8_BAR;
        PG8_STAGE(PG8_SB(1, 0), cB + kstep, voffB); PG8_STAGE_A(PG8_SA(1, 0), cA + kstep, 0, false); PG8_STAGE(PG8_SB(1, 1), cB + hstep + kstep, voffB);
        PG8_WAIT_V(6); PG8_BAR;
    }
#pragma unroll 1
    for (;;) {
        const bool has_next = S.next(ui + 1, nxt);
        const char* nA = has_next ? S.a_base(nxt) : cA; const char* nB = has_next ? S.b_base(nxt) : cB;
        const bool do0 = (wr == 0) || cur.aux > 64, do1 = cur.aux > 128 && ((wr == 0) || cur.aux > 192);
#pragma unroll 1
        for (int t = 0; t < nt; t += 2) {
            const bool last = (t == nt - 2);
            const char* a1 = cA + (size_t)(t + 1) * kstep;
            const char* a2 = last ? nA : cA + (size_t)(t + 2) * kstep; const char* b2 = last ? nB : cB + (size_t)(t + 2) * kstep;
            const char* a3 = a2 + kstep; const char* b3 = b2 + kstep;
            const bool nx2 = last && has_next;
            if constexpr (SP2) {
            PG8_LDB(B0, 0, 0); PG8_LDB(B1, 0, 1); PG8_SCHED; PG8_LDA(At, 0, 0); PG8_STAGE_A(PG8_SA(1, 1), a1, 1, false);
            PG8_WAIT_V(8); PG8_WAIT_L(0); PG8_BAR; PG8_MMA(0, 0, At, B0); PG8_MMA(0, 1, At, B1); PG8_BAR; PG8_SCHED;
            PG8_LDA(At, 0, 1); PG8_STAGE(PG8_SB(0, 0), b2, voffB); PG8_STAGE(PG8_SB(0, 1), b2 + hstep, voffB); PG8_STAGE_A(PG8_SA(0, 0), a2, 0, nx2);
            PG8_WAIT_V(8); PG8_WAIT_L(0); PG8_BAR; PG8_MMA(1, 0, At, B0); PG8_MMA(1, 1, At, B1); PG8_BAR; PG8_SCHED;
            PG8_LDB(B0, 1, 0); PG8_LDB(B1, 1, 1); PG8_SCHED; PG8_LDA(At, 1, 0); PG8_STAGE_A(PG8_SA(0, 1), a2, 1, nx2);
            PG8_WAIT_V(8); PG8_WAIT_L(0); PG8_BAR; PG8_MMA(0, 0, At, B0); PG8_MMA(0, 1, At, B1); PG8_BAR; PG8_SCHED;
            PG8_LDA(At, 1, 1); PG8_STAGE(PG8_SB(1, 0), b3, voffB); PG8_STAGE(PG8_SB(1, 1), b3 + hstep, voffB); PG8_STAGE_A(PG8_SA(1, 0), a3, 0, nx2);
            PG8_WAIT_V(8); PG8_WAIT_L(0); PG8_BAR; PG8_MMA(1, 0, At, B0); PG8_MMA(1, 1, At, B1); PG8_BAR; PG8_SCHED;
            } else {
            PG8_LDB(B0, 0, 0); PG8_SCHED; PG8_LDA(At, 0, 0); PG8_STAGE_A(PG8_SA(1, 1), a1, 1, false);
            PG8_WAIT_L(8); PG8_BAR; PG8_WAIT_L(0); PG8_MMA(0, 0, At, B0); PG8_BAR; PG8_SCHED;
            PG8_LDB(B1, 0, 1); PG8_STAGE(PG8_SB(0, 0), b2, voffB);
            PG8_BAR; PG8_WAIT_L(0); PG8_MMA(0, 1, At, B1); PG8_BAR;
            PG8_LDA(At, 0, 1); PG8_STAGE_A(PG8_SA(0, 0), a2, 0, nx2);
            PG8_BAR; PG8_WAIT_L(0); PG8_MMA(1, 0, At, B0); PG8_BAR; PG8_SCHED;
            PG8_STAGE(PG8_SB(0, 1), b2 + hstep, voffB);
            PG8_WAIT_V(6); PG8_BAR; PG8_MMA(1, 1, At, B1); PG8_BAR;
            PG8_LDB(B0, 1, 0); PG8_SCHED; PG8_LDA(At, 1, 0); PG8_STAGE_A(PG8_SA(0, 1), a2, 1, nx2);
            PG8_WAIT_L(8); PG8_BAR; PG8_WAIT_L(0); PG8_MMA(0, 0, At, B0); PG8_BAR; PG8_SCHED;
            PG8_LDB(B1, 1, 1); PG8_STAGE(PG8_SB(1, 0), b3, voffB);
            PG8_BAR; PG8_WAIT_L(0); PG8_MMA(0, 1, At, B1); PG8_BAR;
            PG8_LDA(At, 1, 1); PG8_STAGE_A(PG8_SA(1, 0), a3, 0, nx2);
            PG8_BAR; PG8_WAIT_L(0); PG8_MMA(1, 0, At, B0); PG8_BAR; PG8_SCHED;
            PG8_STAGE(PG8_SB(1, 1), b3 + hstep, voffB);
            PG8_WAIT_V(6); PG8_BAR; PG8_MMA(1, 1, At, B1); PG8_BAR;
            }
        }
        if constexpr (ALIGN_EPI) { if (wr == 0) PG8_BAR; }
        E(acc, cur, wr, wc, fr, fq);
        if (!has_next) break;
#pragma unroll
        for (int a = 0; a < 2; ++a)
#pragma unroll
            for (int b = 0; b < 2; ++b)
#pragma unroll
                for (int m = 0; m < 4; ++m)
#pragma unroll
                    for (int n = 0; n < 2; ++n) acc[a][b][m][n] = (f32x4){0.f, 0.f, 0.f, 0.f};
        cur = nxt; cA = nA; cB = nB; ++ui;
        if constexpr (ALIGN_EPI) { if (wr == 1) PG8_BAR; }
    }
    PG8_WAIT_V(0);
    if constexpr (!ALIGN_EPI) { if (wr == 0) PG8_BAR; }
    PG8_BAR;
#undef PG8_SA
#undef PG8_SB
#undef PG8_STAGE
#undef PG8_STAGE_A
#undef PG8_LDA
#undef PG8_LDB
#undef PG8_MMA
#undef PG8_WAIT_V
#undef PG8_WAIT_L
#undef PG8_BAR
#undef PG8_SCHED
}
}

struct Args { const void* in[24]; float* out; unsigned char* ws; int ph_lo, ph_hi, flags, pad; };
enum { I_X = 0, I_P, I_POS, I_WIN, I_WGK2, I_BGK, I_GNORM, I_WGO, I_WMO, I_WOUT, I_LN1G, I_LN1B, I_WR, I_BR, I_WEG, I_WEU, I_WED, I_WSG, I_WSU, I_WSD, I_WPLE, I_WPG, I_LN2G, I_LN2B };

__device__ __forceinline__ void p0_transpose_item(const float* W, int ldw, int src_c0, int K, bf16* dst, int k0, LAS float* scr, int lane) {
    float v[32];
#pragma unroll
    for (int i = 0; i < 32; ++i) { const int kk = 2 * i + (lane >> 5); v[i] = __builtin_nontemporal_load(W + (size_t)(k0 + kk) * ldw + src_c0 + (lane & 31)); }
#pragma unroll
    for (int i = 0; i < 32; ++i) { const int kk = 2 * i + (lane >> 5); scr[kk * 33 + (lane & 31)] = v[i]; }
    LDS_WAIT(); asm volatile("" ::: "memory");
    const int c = lane & 7;
#pragma unroll
    for (int j = 0; j < 4; ++j) { const int n = (lane >> 3) + 8 * j; const LAS float* s = scr + (8 * c) * 33 + n;
        v4u o; o.x = pk2(s[0 * 33], s[1 * 33]); o.y = pk2(s[2 * 33], s[3 * 33]); o.z = pk2(s[4 * 33], s[5 * 33]); o.w = pk2(s[6 * 33], s[7 * 33]);
        *(GAS v4u*)(dst + (size_t)n * K + k0 + 8 * c) = o; }
    LDS_WAIT(); asm volatile("" ::: "memory");
}

struct CoopTile { f32x4 v[8]; };
__device__ __forceinline__ void coop_load(CoopTile& t, const float* src, int ldw, int tid) {
    const int c4 = tid & 63, rg = tid >> 6;
#pragma unroll
    for (int i = 0; i < 8; ++i) t.v[i] = __builtin_nontemporal_load((const f32x4*)(src + (size_t)(rg + 8 * i) * ldw) + c4);
}
__device__ __forceinline__ void coop_to_lds(const CoopTile& t, LAS float* tile, int tid) {
    const int c4 = tid & 63, rg = tid >> 6;
#pragma unroll
    for (int i = 0; i < 8; ++i) { const int k = rg + 8 * i; *(LAS f32x4*)(tile + k * 260 + ((4 * c4) ^ (4 * ((k >> 3) & 7)))) = t.v[i]; }
}
template <class RowMap> __device__ __forceinline__ void coop_store(const LAS float* tile, bf16* dst, int K, int k0, const RowMap& rowmap, int tid) {
    const int c = tid & 7, nn = tid >> 3;
#pragma unroll
    for (int q = 0; q < 4; ++q) { const int n = nn + 64 * q; const LAS float* s = tile + (8 * c) * 260 + (n ^ (4 * c));
        v4u o; o.x = pk2(s[0 * 260], s[1 * 260]); o.y = pk2(s[2 * 260], s[3 * 260]); o.z = pk2(s[4 * 260], s[5 * 260]); o.w = pk2(s[6 * 260], s[7 * 260]);
        *(GAS v4u*)(dst + (size_t)rowmap(n) * K + k0 + 8 * c) = o; }
}
struct RowE1 { int half; __device__ __forceinline__ int operator()(int n) const { return (n >> 7) * 256 + half * 128 + (n & 127); } };
struct RowId { __device__ __forceinline__ int operator()(int n) const { return n; } };
__device__ __forceinline__ void coop_item_src(const Args& a, int it, const float*& src, int& ldw) {
    const int e = it / 48, q = it % 48;
    if (q < 32) { src = (const float*)a.in[(q < 16) ? I_WEG : I_WEU] + (size_t)e * 1024 * 256 + (size_t)((q & 15) * 64) * 256; ldw = 256; }
    else { const int kb = (q - 32) >> 2, ns = (q - 32) & 3; src = (const float*)a.in[I_WED] + (size_t)e * 256 * 1024 + (size_t)(kb * 64) * 1024 + ns * 256; ldw = 1024; }
}
__device__ __forceinline__ void coop_item_store(const Args& a, int it, const LAS float* tile, int tid) {
    const int e = it / 48, q = it % 48;
    if (q < 32) coop_store(tile, (bf16*)(a.ws + WS_WE1) + (size_t)e * 512 * 1024, 1024, (q & 15) * 64, RowE1{q >= 16 ? 1 : 0}, tid);
    else { const int kb = (q - 32) >> 2, ns = (q - 32) & 3; coop_store(tile, (bf16*)(a.ws + WS_WE2) + ((size_t)e * 1024 + ns * 256) * 256, 256, kb * 64, RowId{}, tid); }
}

__device__ __forceinline__ void phase0(const Args& a, LAS unsigned char* lds, int vcu, int G) {
    const int tid = threadIdx.x, lane = tid & 63, wave = __builtin_amdgcn_readfirstlane(tid >> 6);
    unsigned char* ws = a.ws;
    LAS float* scr = (LAS float*)(lds + RING_OFF + wave * 16384);
    const int gw = vcu * NWAVES + wave, NGW = G * NWAVES;
    constexpr int IT_IN = 16 * 257;
    constexpr int IT_SQ = 16 * 32;
    constexpr int IT_R = 16 * 8, IT_P = 4 * 32, IT_S1 = 16 * 16, IT_S2 = 4 * 32;
    constexpr int IT_E1 = 16 * 16, IT_E2 = 4 * 32;
    constexpr int N_SMALL = IT_IN + 4 * IT_SQ + IT_R + IT_P + IT_S1 + IT_S2;
    constexpr int N_ALL = N_SMALL + NEXP * (IT_E1 + IT_E2);
    for (int it = gw; it < N_SMALL; it += NGW) {
        int r = it;
        if (r < IT_IN) { const int kb = r / 257, nb = r % 257, n0 = nb * 32; const int src = (n0 < 3072) ? n0 : ((n0 < 8192) ? n0 + 16 : 3072);
            p0_transpose_item((const float*)a.in[I_WIN], IN_COLS, src, 1024, (bf16*)(ws + WS_WIN) + (size_t)n0 * 1024, kb * 64, scr, lane); continue; } r -= IT_IN;
        if (r < 4 * IT_SQ) { const int w = r / IT_SQ, q = r % IT_SQ, kb = q / 32, nb = q % 32;
            const float* src = (const float*)a.in[w == 0 ? I_WGO : (w == 1 ? I_WMO : (w == 2 ? I_WOUT : I_WPG))];
            bf16* dst = (bf16*)(ws + (w == 0 ? WS_WGO : (w == 1 ? WS_WMO : (w == 2 ? WS_WOUT : WS_WPG))));
            p0_transpose_item(src, 1024, nb * 32, 1024, dst + (size_t)nb * 32 * 1024, kb * 64, scr, lane); continue; } r -= 4 * IT_SQ;
        if (r < IT_R) { const int kb = r / 8, nb = r % 8; p0_transpose_item((const float*)a.in[I_WR], 256, nb * 32, 1024, (bf16*)(ws + WS_WR) + (size_t)nb * 32 * 1024, kb * 64, scr, lane); continue; } r -= IT_R;
        if (r < IT_P) { const int kb = r / 32, nb = r % 32; p0_transpose_item((const float*)a.in[I_WPLE], 1024, nb * 32, 256, (bf16*)(ws + WS_WP) + (size_t)nb * 32 * 256, kb * 64, scr, lane); continue; } r -= IT_P;
        if (r < IT_S1) { const int kb = r / 16, nb = r % 16, n0 = nb * 32, j = n0 >> 8, half = (n0 >> 7) & 1, c0 = n0 & 127;
            p0_transpose_item((const float*)a.in[half ? I_WSU : I_WSG], 256, 128 * j + c0, 1024, (bf16*)(ws + WS_WS1) + (size_t)n0 * 1024, kb * 64, scr, lane); continue; } r -= IT_S1;
        p0_transpose_item((const float*)a.in[I_WSD], 1024, (r % 32) * 32, 256, (bf16*)(ws + WS_WS2) + (size_t)(r % 32) * 32 * 256, (r / 32) * 64, scr, lane);
    }
    __syncthreads();
    { LAS float* tile = (LAS float*)(lds + RING_OFF);
      constexpr int N_COOP = NEXP * 48;
      CoopTile tA, tB; const float* src; int ldw;
      int it = vcu;
      if (it < N_COOP) { coop_item_src(a, it, src, ldw); coop_load(tA, src, ldw, tid); }
      if (it + G < N_COOP) { coop_item_src(a, it + G, src, ldw); coop_load(tB, src, ldw, tid); }
      for (; it < N_COOP; it += 2 * G) {
          coop_to_lds(tA, tile, tid);
          LDS_WAIT(); __syncthreads();
          if (it + 2 * G < N_COOP) { coop_item_src(a, it + 2 * G, src, ldw); coop_load(tA, src, ldw, tid); }
          coop_item_store(a, it, tile, tid);
          LDS_WAIT(); __syncthreads();
          if (it + G < N_COOP) {
              coop_to_lds(tB, tile, tid);
              LDS_WAIT(); __syncthreads();
              if (it + 3 * G < N_COOP) { coop_item_src(a, it + 3 * G, src, ldw); coop_load(tB, src, ldw, tid); }
              coop_item_store(a, it + G, tile, tid);
              LDS_WAIT(); __syncthreads();
          }
      } }
    const int gt = vcu * (NWAVES * 64) + tid, NGT = G * NWAVES * 64;
    { const f32x4* x4 = (const f32x4*)a.in[I_X]; v2u* o = (v2u*)(ws + WS_XB);
#pragma unroll 8
      for (int i = gt; i < M * DM / 4; i += NGT) { const f32x4 v = x4[i]; v2u w; w.x = pk2(v[0], v[1]); w.y = pk2(v[2], v[3]); o[i] = w; } }
    { const f32x4* p4 = (const f32x4*)a.in[I_P]; v2u* o = (v2u*)(ws + WS_PB);
#pragma unroll 8
      for (int i = gt; i < M * PLE_DIM / 4; i += NGT) { const f32x4 v = p4[i]; v2u w; w.x = pk2(v[0], v[1]); w.y = pk2(v[2], v[3]); o[i] = w; } }
    { const int* pos = (const int*)a.in[I_POS]; float* cs = (float*)(ws + WS_CS);
      for (int i = gt; i < M * 16; i += NGT) { const int row = i >> 4, f = i & 15;
          const double inv = exp2(-(double)f * (18.931568569324174 / 16.0));
          const double rev = (double)pos[row] * inv * 0.15915494309189535;
          const float fr = (float)(rev - floor(rev));
          cs[row * 32 + f] = __builtin_amdgcn_cosf(fr); cs[row * 32 + 16 + f] = __builtin_amdgcn_sinf(fr); } }
}

namespace epi {
using pg8::f32x4; using pg8::Unit; using pg8::cvt_pk_bf16; using pg8::u32x4; using pg8::u32x2; using pg8::bf_lo; using pg8::bf_hi; using pg8::sigmoidf_; using pg8::siluf_;
constexpr int HALF = 128;
__device__ __forceinline__ u32x4 pack8(f32x4 a, f32x4 b) { u32x4 w; w.x = cvt_pk_bf16(a[0], a[1]); w.y = cvt_pk_bf16(a[2], a[3]); w.z = cvt_pk_bf16(b[0], b[1]); w.w = cvt_pk_bf16(b[2], b[3]); return w; }
__device__ __forceinline__ void unpack8(u32x4 w, f32x4& a, f32x4& b) { a = (f32x4){bf_lo(w.x), bf_hi(w.x), bf_lo(w.y), bf_hi(w.y)}; b = (f32x4){bf_lo(w.z), bf_hi(w.z), bf_lo(w.w), bf_hi(w.w)}; }

struct EpiProj {
    static constexpr bool PERM = true;
    bf16* proj; const float* cs;
    __device__ __forceinline__ void operator()(const f32x4 (&acc)[2][2][4][2], const Unit& u, int wr, int wc, int fr, int fq) const {
        const int row0 = u.pm * 256 + wr * 64 + fr;
        const int pn = u.pn;
        const int mode = (pn >= 8 && pn < 12) ? 1 : ((pn >= 24) ? 2 : ((pn >= 12 && pn < 20) ? 3 : 0));
        const int col0 = pn * 256 + wc * 32 + 8 * fq;
#pragma unroll
        for (int ai = 0; ai < 2; ++ai)
#pragma unroll
            for (int m = 0; m < 4; ++m) {
                const int row = row0 + ai * HALF + m * 16;
                bf16* rowp = proj + (size_t)row * PP + col0;
#pragma unroll
                for (int bj = 0; bj < 2; ++bj) {
                    f32x4 v0 = acc[ai][bj][m][0], v1 = acc[ai][bj][m][1];
                    if (mode == 1) {
#pragma unroll
                        for (int i = 0; i < 4; ++i) { v0[i] = siluf_(v0[i]); v1[i] = siluf_(v1[i]); }
                    } else if (mode == 2) {
#pragma unroll
                        for (int i = 0; i < 4; ++i) { v0[i] = sigmoidf_(v0[i]); v1[i] = sigmoidf_(v1[i]); }
                    } else if (mode == 3) {
                        if (wc == 0) {
                            const float* c = cs + (size_t)row * 32 + 8 * (fq & 1);
                            const f32x4 c0 = *(const f32x4*)c, c1 = *(const f32x4*)(c + 4), s0 = *(const f32x4*)(c + 16), s1 = *(const f32x4*)(c + 20);
                            f32x4 p0, p1;
#pragma unroll
                            for (int i = 0; i < 4; ++i) { p0[i] = __shfl_xor(v0[i], 32); p1[i] = __shfl_xor(v1[i], 32); }
                            if (fq < 2) { v0 = v0 * c0 - p0 * s0; v1 = v1 * c1 - p1 * s1; }
                            else        { v0 = p0 * s0 + v0 * c0; v1 = p1 * s1 + v1 * c1; }
                        }
                    }
                    *(u32x4*)(rowp + bj * HALF) = pack8(v0, v1);
                }
            }
    }
};

template <bool ROWBASE> struct EpiBf16 {
    static constexpr bool PERM = true;
    bf16* O; int ld;
    __device__ __forceinline__ void operator()(const f32x4 (&acc)[2][2][4][2], const Unit& u, int wr, int wc, int fr, int fq) const {
        const int rb = ROWBASE ? u.aux2 : u.pm * 256; const int col0 = u.pn * 256 + wc * 32 + 8 * fq;
#pragma unroll
        for (int ai = 0; ai < 2; ++ai)
#pragma unroll
            for (int m = 0; m < 4; ++m) { const int r = ai * HALF + wr * 64 + m * 16 + fr; if (r < u.aux) { bf16* rowp = O + (size_t)(rb + r) * ld + col0;
#pragma unroll
                for (int bj = 0; bj < 2; ++bj) *(u32x4*)(rowp + bj * HALF) = pack8(acc[ai][bj][m][0], acc[ai][bj][m][1]); } }
    }
};

template <bool ADD> struct EpiGate {
    static constexpr bool PERM = true;
    bf16* merged; const bf16* gate;
    __device__ __forceinline__ void operator()(const f32x4 (&acc)[2][2][4][2], const Unit& u, int wr, int wc, int fr, int fq) const {
        const int col0 = u.pn * 256 + wc * 32 + 8 * fq;
#pragma unroll
        for (int ai = 0; ai < 2; ++ai)
#pragma unroll
            for (int m = 0; m < 4; ++m) { const int row = u.pm * 256 + ai * HALF + wr * 64 + m * 16 + fr;
#pragma unroll
                for (int bj = 0; bj < 2; ++bj) { const int c = col0 + bj * HALF;
                    f32x4 g0, g1; unpack8(*(const u32x4*)(gate + (size_t)row * PP + c), g0, g1);
                    f32x4 v0 = acc[ai][bj][m][0] * g0, v1 = acc[ai][bj][m][1] * g1;
                    bf16* d = merged + (size_t)row * DM + c;
                    if (ADD) { f32x4 o0, o1; unpack8(*(const u32x4*)d, o0, o1); v0 += o0; v1 += o1; }
                    *(u32x4*)d = pack8(v0, v1); } }
    }
};

struct EpiPre1 {
    static constexpr bool PERM = false;
    const float* x; float* pre;
    __device__ __forceinline__ void operator()(const f32x4 (&acc)[2][2][4][2], const Unit& u, int wr, int wc, int fr, int fq) const {
        const int col0 = u.pn * 256 + wc * 32 + 4 * fq;
#pragma unroll
        for (int ai = 0; ai < 2; ++ai)
#pragma unroll
            for (int m = 0; m < 4; ++m) { const size_t off = (size_t)(u.pm * 256 + ai * HALF + wr * 64 + m * 16 + fr) * DM + col0;
#pragma unroll
                for (int bj = 0; bj < 2; ++bj)
#pragma unroll
                    for (int n = 0; n < 2; ++n) { const size_t o = off + bj * HALF + n * 16; *(f32x4*)(pre + o) = *(const f32x4*)(x + o) * ALPHA + acc[ai][bj][m][n]; } }
    }
};

struct EpiF32 {
    static constexpr bool PERM = false;
    float* O; int ld;
    __device__ __forceinline__ void operator()(const f32x4 (&acc)[2][2][4][2], const Unit& u, int wr, int wc, int fr, int fq) const {
        const int col0 = u.pn * 256 + wc * 32 + 4 * fq;
#pragma unroll
        for (int ai = 0; ai < 2; ++ai)
#pragma unroll
            for (int m = 0; m < 4; ++m) { float* rowp = O + (size_t)(u.pm * 256 + ai * HALF + wr * 64 + m * 16 + fr) * ld + col0;
#pragma unroll
                for (int bj = 0; bj < 2; ++bj)
#pragma unroll
                    for (int n = 0; n < 2; ++n) *(f32x4*)(rowp + bj * HALF + n * 16) = acc[ai][bj][m][n]; }
    }
};

struct EpiSwiGLU {
    static constexpr bool PERM = true;
    bf16* H; const float* w;
    __device__ __forceinline__ void operator()(const f32x4 (&acc)[2][2][4][2], const Unit& u, int wr, int wc, int fr, int fq) const {
        const int col0 = u.pn * 128 + wc * 32 + 8 * fq;
#pragma unroll
        for (int ai = 0; ai < 2; ++ai)
#pragma unroll
            for (int m = 0; m < 4; ++m) { const int r = ai * HALF + wr * 64 + m * 16 + fr; if (r < u.aux) {
                f32x4 g0 = acc[ai][0][m][0], g1 = acc[ai][0][m][1]; const f32x4 u0 = acc[ai][1][m][0], u1 = acc[ai][1][m][1];
                const float s = w ? w[u.aux3 + r] : 1.f;
#pragma unroll
                for (int i = 0; i < 4; ++i) { g0[i] = siluf_(g0[i]) * u0[i] * s; g1[i] = siluf_(g1[i]) * u1[i] * s; }
                *(u32x4*)(H + (size_t)(u.aux2 + r) * DEXP + col0) = pack8(g0, g1); } }
    }
};

struct EpiPle {
    static constexpr bool PERM = true;
    const bf16* pw; bf16* ple;
    __device__ __forceinline__ void operator()(const f32x4 (&acc)[2][2][4][2], const Unit& u, int wr, int wc, int fr, int fq) const {
        const int col0 = u.pn * 256 + wc * 32 + 8 * fq;
#pragma unroll
        for (int ai = 0; ai < 2; ++ai)
#pragma unroll
            for (int m = 0; m < 4; ++m) { const size_t off = (size_t)(u.pm * 256 + ai * HALF + wr * 64 + m * 16 + fr) * DM + col0;
#pragma unroll
                for (int bj = 0; bj < 2; ++bj) { f32x4 p0, p1; unpack8(*(const u32x4*)(pw + off + bj * HALF), p0, p1);
                    f32x4 v0 = acc[ai][bj][m][0], v1 = acc[ai][bj][m][1];
#pragma unroll
                    for (int i = 0; i < 4; ++i) { v0[i] = sigmoidf_(v0[i]) * p0[i]; v1[i] = sigmoidf_(v1[i]) * p1[i]; }
                    *(u32x4*)(ple + off + bj * HALF) = pack8(v0, v1); } }
    }
};

struct EpiDown {
    static constexpr bool PERM = true;
    bf16* Y;
    __device__ __forceinline__ void operator()(const f32x4 (&acc)[2][2][4][2], const Unit& u, int wr, int wc, int fr, int fq) const {
        const int col0 = u.pn * 256 + wc * 32 + 8 * fq;
#pragma unroll
        for (int ai = 0; ai < 2; ++ai)
#pragma unroll
            for (int m = 0; m < 4; ++m) { const int r = ai * HALF + wr * 64 + m * 16 + fr; if (r < u.aux) {
                bf16* rowp = Y + (size_t)(u.aux2 + r) * DM + col0;
#pragma unroll
                for (int bj = 0; bj < 2; ++bj) *(u32x4*)(rowp + bj * HALF) = pack8(acc[ai][bj][m][0], acc[ai][bj][m][1]); } }
    }
};
}

namespace moba {
constexpr int D = 128, NW = 8, QBLK = 32, KVBLK = 64, QB = NW * QBLK;
constexpr int PIN = PP, POUT = DM;
constexpr float SCALE = 0.08838834764831845f;
constexpr float THR = 8.f;
constexpr int SHM_V = KVBLK * D * 2, SHM_K = KVBLK * D * 2;
constexpr int LDS_BYTES = 2 * SHM_V + 2 * SHM_K + NW * 64 * 4 + NW * 64 * 4 + NW * 64 * 8 * 4;
typedef short bf16x8 __attribute__((ext_vector_type(8)));
typedef short s16x4 __attribute__((ext_vector_type(4)));
typedef float f32x16 __attribute__((ext_vector_type(16)));
typedef float f32x4 __attribute__((ext_vector_type(4)));
typedef unsigned u32x4 __attribute__((ext_vector_type(4)));

#define KSWZ(row, colB) ((row) * 256 + ((colB) ^ (((row) & 7) << 4)))
#define SBAR() __builtin_amdgcn_sched_barrier(0)
__device__ __forceinline__ int v_st(int k, int c) { const int kk = (k & ~0xC) | ((k & 4) << 1) | ((k & 8) >> 1); return ((kk >> 3) * 4 + (c >> 5)) * 512 + ((kk & 7) * 32 + (c & 31)) * 2; }
__device__ __forceinline__ int v_rd_base(int lane) { return ((lane & 3) << 3) | (((lane >> 2) & 3) << 6) | (((lane >> 4) & 1) << 5) | (((lane >> 5) & 1) << 8); }
constexpr int v_rd_off(int d0, int ks, int half) { return d0 * 512 + ks * 4096 + half * 2048; }
__device__ __forceinline__ int crow(int r, int hi) { return (r & 3) + 8 * (r >> 2) + 4 * hi; }
__device__ __forceinline__ unsigned cvtpk(float lo, float hi) { unsigned r; asm volatile("v_cvt_pk_bf16_f32 %0, %1, %2" : "=v"(r) : "v"(lo), "v"(hi)); return r; }
__device__ __forceinline__ bf16x8 load8(const bf16* p) { return *reinterpret_cast<const bf16x8*>(p); }
__device__ __forceinline__ void mask_tile(f32x16& p0, f32x16& p1, int dq) {
    const float NEG = -__builtin_inff();
#pragma unroll
    for (int r = 0; r < 16; ++r) {
        const int c = (r & 3) + 8 * (r >> 2);
        if (dq - c < 0) p0[r] = NEG;
        if (dq - c - 32 < 0) p1[r] = NEG;
    }
}
__device__ __forceinline__ void mask_all(f32x16& p0, f32x16& p1, bool off) {
    const float NEG = -__builtin_inff();
#pragma unroll
    for (int r = 0; r < 16; ++r) { if (off) p0[r] = NEG; if (off) p1[r] = NEG; }
}
__device__ __forceinline__ void partialSM(f32x16& p0, f32x16& p1, float& m_reg, float& mn, float& alpha) {
    float pmax = p0[0]; for (int r = 1; r < 16; ++r) pmax = fmaxf(pmax, p0[r]); for (int r = 0; r < 16; ++r) pmax = fmaxf(pmax, p1[r]);
    { auto rr = __builtin_amdgcn_permlane32_swap(__float_as_uint(pmax), __float_as_uint(pmax), false, false);
      pmax = fmaxf(__uint_as_float(rr[0]), __uint_as_float(rr[1])); }
    constexpr float C2 = 1.4426950408889634f * SCALE;
    if (__builtin_expect(__all((pmax - m_reg) * SCALE <= THR), 1)) { mn = m_reg; alpha = 1.f; }
    else { mn = fmaxf(m_reg, pmax); alpha = __builtin_amdgcn_exp2f((m_reg - mn) * C2); m_reg = mn; }
    const float mnL = -mn * C2;
    for (int r = 0; r < 16; ++r) p0[r] = fmaf(p0[r], C2, mnL); for (int r = 0; r < 16; ++r) p1[r] = fmaf(p1[r], C2, mnL);
    for (int r = 0; r < 16; ++r) p0[r] = __builtin_amdgcn_exp2f(p0[r]);
}
__device__ __forceinline__ void finishSM(f32x16& p0, f32x16& p1, float alpha, float& l_reg, bf16x8& pa0, bf16x8& pa1, bf16x8& pa2, bf16x8& pa3) {
    for (int r = 0; r < 16; ++r) p1[r] = __builtin_amdgcn_exp2f(p1[r]);
    float ps = 0; for (int r = 0; r < 16; ++r) ps += p0[r]; for (int r = 0; r < 16; ++r) ps += p1[r];
    { auto rr = __builtin_amdgcn_permlane32_swap(__float_as_uint(ps), __float_as_uint(ps), false, false);
      ps = __uint_as_float(rr[0]) + __uint_as_float(rr[1]); }
    l_reg = l_reg * alpha + ps;
#define PK4(P, B_, OUT) do { unsigned a0 = cvtpk(P[B_+0], P[B_+1]), a1 = cvtpk(P[B_+2], P[B_+3]);                          \
        unsigned b0 = cvtpk(P[B_+4], P[B_+5]), b1 = cvtpk(P[B_+6], P[B_+7]);                                             \
        auto r0 = __builtin_amdgcn_permlane32_swap(a0, b0, false, false); auto r1 = __builtin_amdgcn_permlane32_swap(a1, b1, false, false); \
        u32x4 w = {r0[0], r1[0], r0[1], r1[1]}; OUT = *reinterpret_cast<bf16x8*>(&w); } while (0)
    PK4(p0, 0, pa0); PK4(p0, 8, pa1); PK4(p1, 0, pa2); PK4(p1, 8, pa3);
#undef PK4
}
template <int KB>
__device__ __forceinline__ void qkt(f32x16& p0, f32x16& p1, const char* K_lds, int r32, int hi, const bf16x8* qr) {
    p0 = f32x16{}; p1 = f32x16{};
    const char* kb[4];
#pragma unroll
    for (int dd = 0; dd < 4; ++dd) kb[dd] = K_lds + KB * SHM_K + KSWZ(r32, (dd * 16 + hi * 8) * 2);
#pragma unroll
    for (int d0 = 0; d0 < 8; ++d0) { const char* a = kb[d0 & 3] + (d0 >> 2) * 128;
        bf16x8 b0 = *reinterpret_cast<const bf16x8*>(a);
        bf16x8 b1 = *reinterpret_cast<const bf16x8*>(a + 32 * 256);
        p0 = __builtin_amdgcn_mfma_f32_32x32x16_bf16(b0, qr[d0], p0, 0, 0, 0);
        p1 = __builtin_amdgcn_mfma_f32_32x32x16_bf16(b1, qr[d0], p1, 0, 0, 0); }
}
template <int VB>
__device__ __forceinline__ void pv_tile(f32x16* o, int vb0, bf16x8 pa0, bf16x8 pa1, bf16x8 pa2, bf16x8 pa3) {
#define TRRD(dst, off) asm volatile("ds_read_b64_tr_b16 %0, %1 offset:%2" : "=&v"(dst) : "v"(vb0), "i"(off) : "memory")
#define PV_D0(d0) do { s16x4 l0, l1, l2, l3, h0, h1, h2, h3; constexpr int b_ = VB * SHM_V + v_rd_off(d0, 0, 0);   \
        TRRD(l0, b_); TRRD(h0, b_ + 2048); TRRD(l1, b_ + 4096); TRRD(h1, b_ + 6144); TRRD(l2, b_ + 8192); TRRD(h2, b_ + 10240); TRRD(l3, b_ + 12288); TRRD(h3, b_ + 14336); \
        asm volatile("s_waitcnt lgkmcnt(0)" ::: "memory"); SBAR();   \
        o[d0] = __builtin_amdgcn_mfma_f32_32x32x16_bf16(pa0, (bf16x8){l0[0], l0[1], l0[2], l0[3], h0[0], h0[1], h0[2], h0[3]}, o[d0], 0, 0, 0);   \
        o[d0] = __builtin_amdgcn_mfma_f32_32x32x16_bf16(pa1, (bf16x8){l1[0], l1[1], l1[2], l1[3], h1[0], h1[1], h1[2], h1[3]}, o[d0], 0, 0, 0);   \
        o[d0] = __builtin_amdgcn_mfma_f32_32x32x16_bf16(pa2, (bf16x8){l2[0], l2[1], l2[2], l2[3], h2[0], h2[1], h2[2], h2[3]}, o[d0], 0, 0, 0);   \
        o[d0] = __builtin_amdgcn_mfma_f32_32x32x16_bf16(pa3, (bf16x8){l3[0], l3[1], l3[2], l3[3], h3[0], h3[1], h3[2], h3[3]}, o[d0], 0, 0, 0); } while (0)
    PV_D0(0); PV_D0(1); PV_D0(2); PV_D0(3);
#undef PV_D0
#undef TRRD
}

struct BlockRef { const bf16* Q; const bf16* K; const bf16* V; bf16* O; const float* KM; int P0; };
struct Seam { bf16x8 qr[8]; bf16x8 st_v0, st_v1, st_k0, st_k1; };

#define OPQ_TID(t_) int t_ = (int)__builtin_amdgcn_mbcnt_hi(~0u, __builtin_amdgcn_mbcnt_lo(~0u, 0u)); asm volatile("" : "+v"(t_)); t_ += wid * 64
#define VMW() asm volatile("s_waitcnt vmcnt(0)" ::: "memory")
#define VMWN(n) asm volatile("s_waitcnt vmcnt(%0)" :: "i"(n) : "memory")
#define SLOAD_H(Kp, Vp, k0) do { OPQ_TID(t_); const size_t o0_ = (size_t)((k0) + (t_ >> 4)) * PIN + (t_ & 15) * 8, o1_ = o0_ + (size_t)32 * PIN;      \
                         S.st_v0 = load8((Vp) + o0_); S.st_v1 = load8((Vp) + o1_); S.st_k0 = load8((Kp) + o0_); S.st_k1 = load8((Kp) + o1_); } while (0)
#define SWRITE_HK(bf) do { OPQ_TID(t_); const int kws_ = KSWZ(t_ >> 4, (t_ & 15) * 16); *(bf16x8*)(K_lds + (bf) * SHM_K + kws_) = S.st_k0; *(bf16x8*)(K_lds + (bf) * SHM_K + kws_ + 32 * 256) = S.st_k1; } while (0)
#define SWRITE_HV(bf) do { OPQ_TID(t_); const int v0_ = v_st(t_ >> 4, (t_ & 15) * 8), v1_ = v_st(32 + (t_ >> 4), (t_ & 15) * 8); *(bf16x8*)(V_lds + (bf) * SHM_V + v0_) = S.st_v0; *(bf16x8*)(V_lds + (bf) * SHM_V + v1_) = S.st_v1; } while (0)
#define SWRITE_H(bf) do { SWRITE_HV(bf); SWRITE_HK(bf); } while (0)

__device__ __forceinline__ void prime(const BlockRef& cur, char* lds, Seam& S) {
    const int tid = threadIdx.x, wid = __builtin_amdgcn_readfirstlane(tid >> 6), lane = tid & 63, r32 = lane & 31, hi = lane >> 5;
    char* K_lds = lds + 2 * SHM_V;
    for (int d0 = 0; d0 < 8; ++d0) S.qr[d0] = load8(cur.Q + (size_t)(wid * QBLK + r32) * PIN + d0 * 16 + hi * 8);
    SLOAD_H(cur.K, cur.V, 0); VMW(); SWRITE_HK(0);
    __syncthreads();
}

__device__ __forceinline__ unsigned select_blocks(const Seam& S, const float* KM, int qb, int hi, float* sj) {
#pragma unroll 1
    for (int j = 0; j < qb; ++j) {
        float a = 0.f;
#pragma unroll
        for (int d0 = 0; d0 < 8; ++d0) { const float* km = KM + j * 128 + d0 * 16 + hi * 8; const f32x4 k0 = *(const f32x4*)km, k1 = *(const f32x4*)(km + 4);
            const bf16x8 q = S.qr[d0];
#pragma unroll
            for (int i = 0; i < 4; ++i) { a = fmaf(__uint_as_float(((unsigned)(unsigned short)q[i]) << 16), k0[i], a); a = fmaf(__uint_as_float(((unsigned)(unsigned short)q[4 + i]) << 16), k1[i], a); } }
        a += __shfl_xor(a, 32);
        sj[j * 64] = a;
    }
    asm volatile("s_waitcnt lgkmcnt(0)" ::: "memory");
    unsigned sel = 0u;
#pragma unroll 1
    for (int j = 0; j < qb; ++j) { const float sv = sj[j * 64]; int rank = 0;
#pragma unroll 1
        for (int i = 0; i < qb; ++i) { const float si = sj[i * 64]; rank += (i != j && (si > sv || (si == sv && i < j))) ? 1 : 0; }
        if (rank < 3) sel |= 1u << j; }
    return sel;
}

__device__ __forceinline__ void block(const BlockRef& cur, const bf16* nxtQ, char* lds, Seam& S) {
    const int tid = threadIdx.x, wid = __builtin_amdgcn_readfirstlane(tid >> 6), lane = tid & 63, r32 = lane & 31, hi = lane >> 5;
    const int NT = (cur.P0 + QB) / KVBLK;
    const int qlo = cur.P0 + wid * QBLK, qm = qlo + r32 - 4 * hi;
    char* V_lds = lds; char* K_lds = lds + 2 * SHM_V;
    float* ws = (float*)(lds + 2 * SHM_V + 2 * SHM_K) + wid * 64; float* li_l = ws, * al_l = ws + 32;
    float m_reg = -1e30f, l_reg = 0; f32x16 o[4] = {};
    const int vb0 = (int)(uintptr_t)V_lds + v_rd_base(lane);
    const bf16* Kh = cur.K; const bf16* Vh = cur.V;
    unsigned sel; { int lane_o = lane; asm volatile("" : "+v"(lane_o));
      sel = select_blocks(S, cur.KM, cur.P0 >> 8, lane_o >> 5, (float*)(lds + 2 * SHM_V + 2 * SHM_K + 2 * NW * 64 * 4) + wid * 512 + lane_o); }
#define RESC(a) do { if (__any((a) < 1.f)) { if (hi == 0) al_l[r32] = (a); asm volatile("s_waitcnt lgkmcnt(0)" ::: "memory");              \
                     for (int d_ = 0; d_ < 4; ++d_) for (int r = 0; r < 16; ++r) o[d_][r] *= al_l[crow(r, hi)]; } } while (0)
#define KBASE(t) ((t) * KVBLK)
#define MASKT(P0_, P1_, t) do { const int kb_ = KBASE(t); if (kb_ + KVBLK - 1 > qlo) mask_tile(P0_, P1_, qm - kb_);      \
        if (kb_ < cur.P0) { const bool off_ = ((sel >> (kb_ >> 8)) & 1u) == 0u; if (__any(off_)) mask_all(P0_, P1_, off_); } } while (0)
    constexpr int NQL = 8;
#define SEAM_K0() do { VMWN(NQL); SWRITE_HK(0); SBAR(); } while (0)
    f32x16 pA0, pA1, pB0, pB1; float mnA, mnB, alA, alB; bf16x8 pa0, pa1, pa2, pa3;
    SWRITE_HV(0); SBAR();
    if (NT > 1) { SLOAD_H(Kh, Vh, KBASE(1)); }
    SBAR(); qkt<0>(pA0, pA1, K_lds, r32, hi, S.qr);
    MASKT(pA0, pA1, 0); partialSM(pA0, pA1, m_reg, mnA, alA);
    if (NT > 1) { VMW(); SWRITE_H(1); }
    __syncthreads();
#define HALF_STEP(PX0, PX1, mnX, alX, PY0, PY1, alY, t, KB, VB, SB) do {                                                      \
        SBAR(); qkt<KB>(PX0, PX1, K_lds, r32, hi, S.qr);                                                                     \
        finishSM(PY0, PY1, alY, l_reg, pa0, pa1, pa2, pa3); SBAR();                                                           \
        if ((t) + 1 < NT) { SLOAD_H(Kh, Vh, KBASE((t) + 1)); SBAR(); }                                                        \
        pv_tile<VB>(o, vb0, pa0, pa1, pa2, pa3); MASKT(PX0, PX1, (t)); partialSM(PX0, PX1, m_reg, mnX, alX);                  \
        __syncthreads();                                                                                                      \
        if ((t) + 1 < NT) { VMW(); SWRITE_H(SB); }                                                                            \
        RESC(alX); __syncthreads(); } while (0)
    for (int t = 1; t + 1 < NT; t += 2) {
        HALF_STEP(pB0, pB1, mnB, alB, pA0, pA1, alA, t, 1, 0, 0);
        HALF_STEP(pA0, pA1, mnA, alA, pB0, pB1, alB, t + 1, 0, 1, 1);
    }
    const bool even = (NT & 1) == 0;
    if (even) { SBAR(); qkt<1>(pB0, pB1, K_lds, r32, hi, S.qr); SBAR(); }
    SLOAD_H(cur.K, cur.V, 0); SBAR();
#pragma unroll
    for (int d0 = 0; d0 < 8; ++d0) S.qr[d0] = load8(nxtQ + (size_t)(wid * QBLK + r32) * PIN + d0 * 16 + hi * 8);
    SBAR();
    finishSM(pA0, pA1, alA, l_reg, pa0, pa1, pa2, pa3); SBAR();
    pv_tile<0>(o, vb0, pa0, pa1, pa2, pa3);
    if (even) { MASKT(pB0, pB1, NT - 1); partialSM(pB0, pB1, m_reg, mnB, alB); __syncthreads(); RESC(alB);
        finishSM(pB0, pB1, alB, l_reg, pa0, pa1, pa2, pa3); SBAR(); pv_tile<1>(o, vb0, pa0, pa1, pa2, pa3); }
    SBAR(); SEAM_K0();
    if (hi == 0) li_l[r32] = l_reg; asm volatile("s_waitcnt lgkmcnt(0)" ::: "memory");
    float rli[16];
#pragma unroll
    for (int r = 0; r < 16; ++r) rli[r] = __builtin_amdgcn_rcpf(li_l[crow(r, hi)]);
    bf16* Ow = cur.O + (size_t)(wid * QBLK) * POUT;
#pragma unroll
    for (int r = 0; r < 16; ++r) { const int orow = crow(r, hi);
#pragma unroll
        for (int d0 = 0; d0 < 4; ++d0) { const float v = o[d0][r] * rli[r];
            const float vn = __shfl_xor(v, 1);
            if ((r32 & 1) == 0) *(unsigned*)(Ow + (size_t)orow * POUT + d0 * 32 + r32) = cvtpk(v, vn); } }
    __syncthreads();
#undef RESC
#undef KBASE
#undef MASKT
#undef SEAM_K0
#undef HALF_STEP
}
#undef OPQ_TID
#undef VMW
#undef VMWN
#undef SLOAD_H
#undef SWRITE_HK
#undef SWRITE_HV
#undef SWRITE_H
#undef KSWZ
#undef SBAR
}

namespace gla {
typedef short bf16x8 __attribute__((ext_vector_type(8)));
typedef float f32x4 __attribute__((ext_vector_type(4)));
constexpr int PQ = 136, PT = 72;
constexpr int EW = 128;
constexpr int O_QE = 0, O_KE = O_QE + 64 * PQ * 2, O_KDT = O_KE + 64 * PQ * 2, O_VT = O_KDT + 128 * PT * 2, O_ATT = O_VT + EW * PT * 2, O_ST = O_ATT + 64 * PT * 2,
              O_SEG = O_ST + EW * PQ * 2, O_DEC = O_SEG + 8 * 128 * 4, O_LOW = O_DEC + 128 * 4, O_END = O_LOW + 64 * 16 * 4;
static_assert(O_END <= RING_BYTES, "gla LDS");
__device__ __forceinline__ f32x4 mma(bf16x8 a, bf16x8 b, f32x4 c) { return __builtin_amdgcn_mfma_f32_16x16x32_bf16(a, b, c, 0, 0, 0); }
template <int KK>
__device__ __forceinline__ f32x4 tile_mm(const LAS bf16* X, int px, int i0, const LAS bf16* Y, int py, int j0, f32x4 c, int l15, int lq) {
#pragma unroll
    for (int kk = 0; kk < KK; ++kk) {
        const bf16x8 a = *(const LAS bf16x8*)(X + (i0 + l15) * px + kk * 32 + lq * 8);
        const bf16x8 b = *(const LAS bf16x8*)(Y + (j0 + l15) * py + kk * 32 + lq * 8);
        c = mma(a, b, c);
    }
    return c;
}
__device__ __forceinline__ float logsigmoidf_(float x) { return fminf(x, 0.f) - __logf(1.f + __expf(-fabsf(x))); }

constexpr size_t G_QE = 64 * 128 * 2, G_KDT = 128 * 64 * 2, G_ATT = 64 * 64 * 2, G_DEC = 128 * 4;
__device__ __forceinline__ void prep(const Args& a, LAS unsigned char* lds, int it) {
    const int tid = threadIdx.x, lane = tid & 63, wave = __builtin_amdgcn_readfirstlane(tid >> 6), l15 = lane & 15, lq = lane >> 4;
    const int n = it & 31, h = (it >> 5) & 3, b = it >> 7;
    unsigned char* ws = a.ws;
    const bf16* proj = (const bf16*)(ws + WS_PROJ); const float* lowg = (const float*)(ws + WS_LOW);
    LAS bf16* QE = (LAS bf16*)(lds + O_QE); LAS bf16* KE = (LAS bf16*)(lds + O_KE); LAS bf16* KDT = (LAS bf16*)(lds + O_KDT);
    LAS bf16* ATT = (LAS bf16*)(lds + O_ATT); LAS float* SEG = (LAS float*)(lds + O_SEG); LAS float* DEC = (LAS float*)(lds + O_DEC); LAS float* LOWS = (LAS float*)(lds + O_LOW);
    const int dp = lane, cg = wave;
    const size_t r0 = (size_t)b * SEQ + (size_t)n * 64;
    if (tid < 256) *(LAS f32x4*)(LOWS + tid * 4) = *(const f32x4*)(lowg + r0 * 16 + tid * 4);
    unsigned qv[8], kv[8];
#pragma unroll
    for (int i = 0; i < 8; ++i) { const bf16* p = proj + (r0 + 8 * cg + i) * PP + h * 128 + 2 * dp; qv[i] = *(const unsigned*)(p + C_GQ); kv[i] = *(const unsigned*)(p + C_GK); }
    float w2[16][2], bg[2];
    { const float* W2 = (const float*)a.in[I_WGK2] + h * 128 + 2 * dp; const float* BG = (const float*)a.in[I_BGK] + h * 128 + 2 * dp;
#pragma unroll
      for (int j = 0; j < 16; ++j) { w2[j][0] = W2[j * 512]; w2[j][1] = W2[j * 512 + 1]; }
      bg[0] = BG[0]; bg[1] = BG[1]; }
    LDS_WAIT(); __syncthreads();
    float bl[8][2];
    { float run0 = 0.f, run1 = 0.f;
#pragma unroll
      for (int i = 0; i < 8; ++i) { const LAS float* lw = LOWS + (8 * cg + i) * 16; float x0 = bg[0], x1 = bg[1];
#pragma unroll
          for (int j = 0; j < 16; ++j) { const float l = lw[j]; x0 = fmaf(l, w2[j][0], x0); x1 = fmaf(l, w2[j][1], x1); }
          run0 += logsigmoidf_(x0) * 0.0625f; run1 += logsigmoidf_(x1) * 0.0625f; bl[i][0] = run0; bl[i][1] = run1; }
      SEG[cg * 128 + 2 * dp] = run0; SEG[cg * 128 + 2 * dp + 1] = run1; }
    LDS_WAIT(); __syncthreads();
    { float off0 = 0.f, off1 = 0.f, tot0 = 0.f, tot1 = 0.f;
#pragma unroll
      for (int g = 0; g < 8; ++g) { const float s0 = SEG[g * 128 + 2 * dp], s1 = SEG[g * 128 + 2 * dp + 1]; if (g < cg) { off0 += s0; off1 += s1; } tot0 += s0; tot1 += s1; }
      unsigned kd0[4], kd1[4];
#pragma unroll
      for (int i = 0; i < 8; ++i) { const float b0 = bl[i][0] + off0, b1 = bl[i][1] + off1;
          const float q0 = pg8::bf_lo(qv[i]) * 0.08838834764831845f, q1 = pg8::bf_hi(qv[i]) * 0.08838834764831845f, k0 = pg8::bf_lo(kv[i]), k1 = pg8::bf_hi(kv[i]);
          const float e0 = __expf(b0), e1 = __expf(b1), i0 = __expf(-b0), i1 = __expf(-b1), d0 = __expf(tot0 - b0), d1 = __expf(tot1 - b1);
          *(LAS unsigned*)(QE + (8 * cg + i) * PQ + 2 * dp) = pk2(q0 * e0, q1 * e1);
          *(LAS unsigned*)(KE + (8 * cg + i) * PQ + 2 * dp) = pk2(k0 * i0, k1 * i1);
          const unsigned a0 = f2bf(k0 * d0), a1 = f2bf(k1 * d1);
          if (i & 1) { kd0[i >> 1] |= a0 << 16; kd1[i >> 1] |= a1 << 16; } else { kd0[i >> 1] = a0; kd1[i >> 1] = a1; } }
      *(LAS v4u*)(KDT + (2 * dp) * PT + 8 * cg) = (v4u){kd0[0], kd0[1], kd0[2], kd0[3]};
      *(LAS v4u*)(KDT + (2 * dp + 1) * PT + 8 * cg) = (v4u){kd1[0], kd1[1], kd1[2], kd1[3]};
      if (cg == 0) { DEC[2 * dp] = __expf(tot0); DEC[2 * dp + 1] = __expf(tot1); } }
    LDS_WAIT(); __syncthreads();
#pragma unroll
    for (int q = 0; q < 2; ++q) { const int idx = 2 * wave + q, ti = idx >> 2, tj = idx & 3;
        f32x4 c = (f32x4){0.f, 0.f, 0.f, 0.f};
        if (tj <= ti) c = tile_mm<4>(KE, PQ, 16 * tj, QE, PQ, 16 * ti, c, l15, lq);
        const int cc = 16 * ti + l15, s0 = 16 * tj + 4 * lq;
        v2u w; w.x = pk2(s0 + 0 <= cc ? c[0] : 0.f, s0 + 1 <= cc ? c[1] : 0.f); w.y = pk2(s0 + 2 <= cc ? c[2] : 0.f, s0 + 3 <= cc ? c[3] : 0.f);
        *(LAS v2u*)(ATT + cc * PT + s0) = w; }
    LDS_WAIT(); __syncthreads();
    { unsigned char* gq = ws + WS_GQE + (size_t)it * G_QE; unsigned char* gk = ws + WS_GKDT + (size_t)it * G_KDT; unsigned char* ga = ws + WS_GATT + (size_t)it * G_ATT;
#pragma unroll
      for (int j = 0; j < 2; ++j) { const int pc = tid + 512 * j;
          { const int r = pc >> 4, c8 = (pc & 15) * 8; *(v4u*)(gq + (size_t)pc * 16) = *(const LAS v4u*)(QE + r * PQ + c8); }
          { const int r = pc >> 3, c8 = (pc & 7) * 8;  *(v4u*)(gk + (size_t)pc * 16) = *(const LAS v4u*)(KDT + r * PT + c8); } }
      { const int r = tid >> 3, c8 = (tid & 7) * 8; *(v4u*)(ga + (size_t)tid * 16) = *(const LAS v4u*)(ATT + r * PT + c8); }
      if (tid < 128) ((float*)(ws + WS_GDEC + (size_t)it * G_DEC))[tid] = DEC[tid]; }
    LDS_WAIT(); __syncthreads();
}

__device__ __forceinline__ void scan(const Args& a, LAS unsigned char* lds, int b, int h, int es) {
    const int tid = threadIdx.x, lane = tid & 63, wave = __builtin_amdgcn_readfirstlane(tid >> 6), l15 = lane & 15, lq = lane >> 4;
    unsigned char* ws = a.ws;
    const bf16* proj = (const bf16*)(ws + WS_PROJ); bf16* og = (bf16*)(ws + WS_OG);
    LAS bf16* QE = (LAS bf16*)(lds + O_QE); LAS bf16* KDT = (LAS bf16*)(lds + O_KDT); LAS bf16* VT = (LAS bf16*)(lds + O_VT);
    LAS bf16* ATT = (LAS bf16*)(lds + O_ATT); LAS bf16* ST = (LAS bf16*)(lds + O_ST); LAS float* DEC = (LAS float*)(lds + O_DEC);
    for (int i = tid; i < EW * PQ / 2; i += NWAVES * 64) ((LAS unsigned*)ST)[i] = 0u;
    f32x4 Sreg[8];
#pragma unroll
    for (int t = 0; t < 8; ++t) Sreg[t] = (f32x4){0.f, 0.f, 0.f, 0.f};
    const size_t rowbase = (size_t)b * SEQ; const int it0 = (b * 4 + h) * 32;
    const int vc = tid >> 3, ve0 = (tid & 7) * 16;
    v4u q0, q1, k0, k1, at, vv0, vv1; float dc = 0.f;
#define GLA_LOAD(n_) do { const size_t it_ = (size_t)(it0 + (n_)); const size_t r0_ = rowbase + (size_t)(n_) * 64;                                   \
        q0 = *(const v4u*)(ws + WS_GQE + it_ * G_QE + (size_t)tid * 16); q1 = *(const v4u*)(ws + WS_GQE + it_ * G_QE + (size_t)(tid + 512) * 16);     \
        k0 = *(const v4u*)(ws + WS_GKDT + it_ * G_KDT + (size_t)tid * 16); k1 = *(const v4u*)(ws + WS_GKDT + it_ * G_KDT + (size_t)(tid + 512) * 16); \
        at = *(const v4u*)(ws + WS_GATT + it_ * G_ATT + (size_t)tid * 16);                                                                           \
        { const bf16* p = proj + (r0_ + vc) * PP + C_GV + h * 256 + es * EW + ve0; vv0 = *(const v4u*)p; vv1 = *(const v4u*)(p + 8); }                 \
        if (tid < 128) dc = ((const float*)(ws + WS_GDEC + it_ * G_DEC))[tid]; } while (0)
    GLA_LOAD(0);
    for (int n = 0; n < SEQ / 64; ++n) {
        const size_t r0 = rowbase + (size_t)n * 64;
        { { const int r = tid >> 4, c8 = (tid & 15) * 8; *(LAS v4u*)(QE + r * PQ + c8) = q0; *(LAS v4u*)(QE + (r + 32) * PQ + c8) = q1; }
          { const int r = tid >> 3, c8 = (tid & 7) * 8; *(LAS v4u*)(KDT + r * PT + c8) = k0; *(LAS v4u*)(KDT + (r + 64) * PT + c8) = k1; *(LAS v4u*)(ATT + r * PT + c8) = at; }
          { const unsigned vw[8] = {vv0.x, vv0.y, vv0.z, vv0.w, vv1.x, vv1.y, vv1.z, vv1.w};
#pragma unroll
            for (int j = 0; j < 8; ++j) { VT[(ve0 + 2 * j) * PT + vc] = (bf16)(vw[j] & 0xffffu); VT[(ve0 + 2 * j + 1) * PT + vc] = (bf16)(vw[j] >> 16); } }
          if (tid < 128) DEC[tid] = dc;
          if (n > 0) {
#pragma unroll
              for (int te = 0; te < 8; ++te) { v2u w; w.x = pk2(Sreg[te][0], Sreg[te][1]); w.y = pk2(Sreg[te][2], Sreg[te][3]); *(LAS v2u*)(ST + (16 * te + l15) * PQ + 16 * wave + 4 * lq) = w; } } }
        if (n + 1 < SEQ / 64) GLA_LOAD(n + 1);
        LDS_WAIT(); __syncthreads();
        { const int tc = wave >> 1;
#pragma unroll
          for (int q = 0; q < 4; ++q) { const int te = 4 * (wave & 1) + q;
              f32x4 o = (f32x4){0.f, 0.f, 0.f, 0.f};
              o = tile_mm<2>(VT, PT, 16 * te, ATT, PT, 16 * tc, o, l15, lq);
              o = tile_mm<4>(ST, PQ, 16 * te, QE, PQ, 16 * tc, o, l15, lq);
              v2u w; w.x = pk2(o[0], o[1]); w.y = pk2(o[2], o[3]);
              *(v2u*)(og + (r0 + 16 * tc + l15) * DM + h * 256 + es * EW + 16 * te + 4 * lq) = w; } }
        { const f32x4 dec = *(const LAS f32x4*)(DEC + 16 * wave + 4 * lq);
#pragma unroll
          for (int te = 0; te < 8; ++te) { f32x4 u = Sreg[te] * dec; u = tile_mm<2>(KDT, PT, 16 * wave, VT, PT, 16 * te, u, l15, lq); Sreg[te] = u; } }
        LDS_WAIT(); __syncthreads();
    }
#undef GLA_LOAD
}
}

__device__ __forceinline__ void phase_kmean(const Args& a, LAS unsigned char* lds, int vcu, int G) {
    const int tid = threadIdx.x;
    const bf16* proj = (const bf16*)(a.ws + WS_PROJ); float* km = (float*)(a.ws + WS_KMEAN);
    LAS float* red = (LAS float*)(lds);
    for (int it = vcu; it < BATCH * MOBA_H * MOBA_NB; it += G) {
        const int blk = it & 7, h = (it >> 3) & 7, b = it >> 6;
        const int c8 = (tid & 15) * 8, rg = tid >> 4;
        const bf16* p = proj + ((size_t)b * SEQ + blk * 256 + rg) * PP + C_MK + h * 128 + c8;
        v4u w[8];
#pragma unroll
        for (int r = 0; r < 8; ++r) w[r] = *(const v4u*)(p + (size_t)(32 * r) * PP);
        float s[8] = {0.f, 0.f, 0.f, 0.f, 0.f, 0.f, 0.f, 0.f};
#pragma unroll
        for (int r = 0; r < 8; ++r) { s[0] += pg8::bf_lo(w[r].x); s[1] += pg8::bf_hi(w[r].x); s[2] += pg8::bf_lo(w[r].y); s[3] += pg8::bf_hi(w[r].y); s[4] += pg8::bf_lo(w[r].z); s[5] += pg8::bf_hi(w[r].z); s[6] += pg8::bf_lo(w[r].w); s[7] += pg8::bf_hi(w[r].w); }
        *(LAS f32x4*)(red + rg * 128 + c8) = (f32x4){s[0], s[1], s[2], s[3]}; *(LAS f32x4*)(red + rg * 128 + c8 + 4) = (f32x4){s[4], s[5], s[6], s[7]};
        LDS_WAIT(); __syncthreads();
        if (tid < 128) { float t = 0.f;
#pragma unroll
            for (int g = 0; g < 32; ++g) t += red[g * 128 + tid];
            km[(size_t)it * 128 + tid] = t * (1.0f / 256.0f); }
        __syncthreads();
    }
}

__device__ __forceinline__ void phase_lowrank(const Args& a, LAS unsigned char* lds, int bx, int G) {
    const int tid = threadIdx.x, lane = tid & 63, wave = __builtin_amdgcn_readfirstlane(tid >> 6), l15 = lane & 15, lq = lane >> 4;
    const bf16* xb = (const bf16*)(a.ws + WS_XB); const bf16* wl = (const bf16*)(a.ws + WS_WIN) + (size_t)PP * DM; float* low = (float*)(a.ws + WS_LOW);
    LAS f32x4* red = (LAS f32x4*)lds;
    for (int blk = bx; blk < M / 64; blk += G) {
        const int rt = wave & 3, kh = wave >> 2;
        const bf16* ap = xb + (size_t)(blk * 64 + rt * 16 + l15) * DM + kh * 512 + lq * 8; const bf16* bp = wl + (size_t)l15 * DM + kh * 512 + lq * 8;
        f32x4 c = (f32x4){0.f, 0.f, 0.f, 0.f};
#pragma unroll
        for (int kk = 0; kk < 16; ++kk) { const bf16x8 av = *(const bf16x8*)(ap + kk * 32), bv = *(const bf16x8*)(bp + kk * 32); c = __builtin_amdgcn_mfma_f32_16x16x32_bf16(av, bv, c, 0, 0, 0); }
        if (kh == 1) red[rt * 64 + lane] = c;
        LDS_WAIT(); __syncthreads();
        if (kh == 0) { c += red[rt * 64 + lane];
#pragma unroll
            for (int r = 0; r < 4; ++r) low[(size_t)(blk * 64 + rt * 16 + 4 * lq + r) * 16 + l15] = c[r]; }
        __syncthreads();
    }
}

__device__ __forceinline__ void phase_glanorm(const Args& a, int vcu, int G) {
    const int tid = threadIdx.x, lane = tid & 63, wave = __builtin_amdgcn_readfirstlane(tid >> 6);
    const bf16* og = (const bf16*)(a.ws + WS_OG); const bf16* proj = (const bf16*)(a.ws + WS_PROJ); bf16* a1 = (bf16*)(a.ws + WS_A1);
    const float* gn = (const float*)a.in[I_GNORM] + ((16 * lane) & 255);
    float g[16];
#pragma unroll
    for (int i = 0; i < 16; ++i) g[i] = gn[i];
    const int gw = vcu * NWAVES + wave, NGW = G * NWAVES;
    for (int m = gw; m < M; m += NGW) {
        const v4u o0 = *(const v4u*)(og + (size_t)m * DM + 16 * lane), o1 = *(const v4u*)(og + (size_t)m * DM + 16 * lane + 8);
        const v4u r0 = *(const v4u*)(proj + (size_t)m * PP + C_GR + 16 * lane), r1 = *(const v4u*)(proj + (size_t)m * PP + C_GR + 16 * lane + 8);
        float v[16], r[16];
        v[0] = pg8::bf_lo(o0.x); v[1] = pg8::bf_hi(o0.x); v[2] = pg8::bf_lo(o0.y); v[3] = pg8::bf_hi(o0.y); v[4] = pg8::bf_lo(o0.z); v[5] = pg8::bf_hi(o0.z); v[6] = pg8::bf_lo(o0.w); v[7] = pg8::bf_hi(o0.w);
        v[8] = pg8::bf_lo(o1.x); v[9] = pg8::bf_hi(o1.x); v[10] = pg8::bf_lo(o1.y); v[11] = pg8::bf_hi(o1.y); v[12] = pg8::bf_lo(o1.z); v[13] = pg8::bf_hi(o1.z); v[14] = pg8::bf_lo(o1.w); v[15] = pg8::bf_hi(o1.w);
        r[0] = pg8::bf_lo(r0.x); r[1] = pg8::bf_hi(r0.x); r[2] = pg8::bf_lo(r0.y); r[3] = pg8::bf_hi(r0.y); r[4] = pg8::bf_lo(r0.z); r[5] = pg8::bf_hi(r0.z); r[6] = pg8::bf_lo(r0.w); r[7] = pg8::bf_hi(r0.w);
        r[8] = pg8::bf_lo(r1.x); r[9] = pg8::bf_hi(r1.x); r[10] = pg8::bf_lo(r1.y); r[11] = pg8::bf_hi(r1.y); r[12] = pg8::bf_lo(r1.z); r[13] = pg8::bf_hi(r1.z); r[14] = pg8::bf_lo(r1.w); r[15] = pg8::bf_hi(r1.w);
        float ss = 0.f;
#pragma unroll
        for (int i = 0; i < 16; ++i) ss = fmaf(v[i], v[i], ss);
        ss += __shfl_xor(ss, 1); ss += __shfl_xor(ss, 2); ss += __shfl_xor(ss, 4); ss += __shfl_xor(ss, 8);
        const float rs = 1.0f / sqrtf(ss * (1.0f / 256.0f) + LN_EPS);
        v4u w0, w1;
        w0.x = pk2(v[0] * rs * g[0] * r[0], v[1] * rs * g[1] * r[1]); w0.y = pk2(v[2] * rs * g[2] * r[2], v[3] * rs * g[3] * r[3]);
        w0.z = pk2(v[4] * rs * g[4] * r[4], v[5] * rs * g[5] * r[5]); w0.w = pk2(v[6] * rs * g[6] * r[6], v[7] * rs * g[7] * r[7]);
        w1.x = pk2(v[8] * rs * g[8] * r[8], v[9] * rs * g[9] * r[9]); w1.y = pk2(v[10] * rs * g[10] * r[10], v[11] * rs * g[11] * r[11]);
        w1.z = pk2(v[12] * rs * g[12] * r[12], v[13] * rs * g[13] * r[13]); w1.w = pk2(v[14] * rs * g[14] * r[14], v[15] * rs * g[15] * r[15]);
        *(v4u*)(a1 + (size_t)m * DM + 16 * lane) = w0; *(v4u*)(a1 + (size_t)m * DM + 16 * lane + 8) = w1;
    }
}

__device__ __forceinline__ void phase_ln1(const Args& a, int vcu, int G) {
    const int tid = threadIdx.x, lane = tid & 63, wave = __builtin_amdgcn_readfirstlane(tid >> 6);
    const float* pre = (const float*)(a.ws + WS_PRE1); bf16* h1b = (bf16*)(a.ws + WS_H1B);
    const f32x4* g4 = (const f32x4*)a.in[I_LN1G] + lane; const f32x4* b4 = (const f32x4*)a.in[I_LN1B] + lane;
    f32x4 gg[4], bb[4];
#pragma unroll
    for (int j = 0; j < 4; ++j) { gg[j] = g4[64 * j]; bb[j] = b4[64 * j]; }
    const int gw = vcu * NWAVES + wave, NGW = G * NWAVES;
    for (int m = gw; m < M; m += NGW) {
        const f32x4* xr = (const f32x4*)(pre + (size_t)m * DM) + lane;
        f32x4 v[4]; float s = 0.f;
#pragma unroll
        for (int j = 0; j < 4; ++j) { v[j] = xr[64 * j]; s += (v[j][0] + v[j][1]) + (v[j][2] + v[j][3]); }
        const float mean = wave_sum(s) * (1.f / DM); float s2 = 0.f;
#pragma unroll
        for (int j = 0; j < 4; ++j) { v[j] = v[j] - mean; s2 += (v[j][0] * v[j][0] + v[j][1] * v[j][1]) + (v[j][2] * v[j][2] + v[j][3] * v[j][3]); }
        const float rstd = 1.f / sqrtf(wave_sum(s2) * (1.f / DM) + LN_EPS);
        v2u* o8 = (v2u*)(h1b + (size_t)m * DM) + lane;
#pragma unroll
        for (int j = 0; j < 4; ++j) { const f32x4 y = v[j] * rstd * gg[j] + bb[j]; v2u w; w.x = pk2(y[0], y[1]); w.y = pk2(y[2], y[3]); o8[64 * j] = w; }
    }
}

__device__ __forceinline__ void phase_route(const Args& a, int vcu, int G) {
    constexpr int RT = 4;
    const int tid = threadIdx.x, lane = tid & 63, wave = __builtin_amdgcn_readfirstlane(tid >> 6);
    const float* logits = (const float*)(a.ws + WS_LOGITS);
    unsigned* counts = (unsigned*)(a.ws + WS_CTL) + CW_COUNTS;
    int* list = (int*)(a.ws + WS_LIST); float* wlist = (float*)(a.ws + WS_WLIST); int* tope = (int*)(a.ws + WS_TOPE); int* topp = (int*)(a.ws + WS_TOPP);
    const f32x4 bias = *((const f32x4*)a.in[I_BR] + lane);
    const int gw = vcu * NWAVES + wave, NGW = G * NWAVES;
    const float NEG = -__builtin_inff();
    for (int t0 = gw * RT; t0 < M; t0 += NGW * RT) {
        float sc[RT][4], cand[RT][4]; int my_e[RT]; float my_s[RT], ssum[RT];
#pragma unroll
        for (int u = 0; u < RT; ++u) {
            const f32x4 lg = *((const f32x4*)(logits + (size_t)(t0 + u) * NEXP) + lane);
            float bi[4];
#pragma unroll
            for (int i = 0; i < 4; ++i) { sc[u][i] = 1.0f / (1.0f + __expf(-lg[i])); bi[i] = sc[u][i] + bias[i]; }
            float m1 = fmaxf(fmaxf(bi[0], bi[1]), fmaxf(bi[2], bi[3]));
            float m2; { const float a0 = fmaxf(bi[0], bi[1]), b0 = fminf(bi[0], bi[1]), a1 = fmaxf(bi[2], bi[3]), b1 = fminf(bi[2], bi[3]); m2 = fmaxf(fminf(a0, a1), fmaxf(b0, b1)); }
#pragma unroll
            for (int o = 1; o < 8; o <<= 1) { const float o1 = __shfl_xor(m1, o), o2 = __shfl_xor(m2, o); const float n1 = fmaxf(m1, o1), n2 = fmaxf(fminf(m1, o1), fmaxf(m2, o2)); m1 = n1; m2 = n2; }
            const float gs = m1 + m2; const int grp = lane >> 3;
            int rank = 0;
#pragma unroll
            for (int g = 0; g < 8; ++g) { const float og = __shfl(gs, 8 * g); rank += (og > gs || (og == gs && g < grp)) ? 1 : 0; }
            const bool gsel = rank < TOPKG;
#pragma unroll
            for (int i = 0; i < 4; ++i) cand[u][i] = gsel ? bi[i] : NEG;
            my_e[u] = 0; my_s[u] = 0.f; ssum[u] = 0.f;
        }
#pragma unroll 1
        for (int k = 0; k < TOPK; ++k) {
            float bv[RT]; int bidx[RT];
#pragma unroll
            for (int u = 0; u < RT; ++u) { bv[u] = cand[u][0]; bidx[u] = 4 * lane;
#pragma unroll
                for (int i = 1; i < 4; ++i) if (cand[u][i] > bv[u]) { bv[u] = cand[u][i]; bidx[u] = 4 * lane + i; } }
#pragma unroll
            for (int o = 1; o < 64; o <<= 1) {
#pragma unroll
                for (int u = 0; u < RT; ++u) { const float ov = __shfl_xor(bv[u], o); const int oi = __shfl_xor(bidx[u], o); if (ov > bv[u] || (ov == bv[u] && oi < bidx[u])) { bv[u] = ov; bidx[u] = oi; } } }
#pragma unroll
            for (int u = 0; u < RT; ++u) { float s = 0.f;
#pragma unroll
                for (int i = 0; i < 4; ++i) if (bidx[u] == 4 * lane + i) { s = sc[u][i]; cand[u][i] = NEG; }
                s = __shfl(s, bidx[u] >> 2);
                ssum[u] += s;
                if (lane == k) { my_e[u] = bidx[u]; my_s[u] = s; } }
        }
        if (lane < TOPK) {
#pragma unroll
            for (int u = 0; u < RT; ++u) { const int t = t0 + u;
                const float w = my_s[u] / ssum[u] * ROUTED_SCALE;
                const unsigned pos = atomicAdd(&counts[my_e[u]], 1u);
                list[(size_t)my_e[u] * M + pos] = t; wlist[(size_t)my_e[u] * M + pos] = w;
                tope[t * TOPK + lane] = my_e[u]; topp[t * TOPK + lane] = (int)pos; }
        }
    }
}

__device__ __forceinline__ void phase_final(const Args& a, LAS unsigned char* lds, int vcu, int G) {
    const int tid = threadIdx.x, lane = tid & 63, wave = __builtin_amdgcn_readfirstlane(tid >> 6);
    const unsigned* counts = (const unsigned*)(a.ws + WS_CTL) + CW_COUNTS;
    LAS int* off = (LAS int*)(lds + TAB_OFF);
    if (tid < 256) off[tid + 1] = (int)counts[tid];
    LDS_WAIT(); __syncthreads();
    if (tid == 0) { int s = 0; off[0] = 0; for (int e = 1; e <= 256; ++e) { s += off[e]; off[e] = s; } }
    LDS_WAIT(); __syncthreads();
    const bf16* h1b = (const bf16*)(a.ws + WS_H1B); const bf16* ys = (const bf16*)(a.ws + WS_YS); const bf16* ysh = (const bf16*)(a.ws + WS_YSH); const bf16* ple = (const bf16*)(a.ws + WS_PLE);
    const int* tope = (const int*)(a.ws + WS_TOPE); const int* topp = (const int*)(a.ws + WS_TOPP);
    const f32x4* g4 = (const f32x4*)a.in[I_LN2G] + lane; const f32x4* b4 = (const f32x4*)a.in[I_LN2B] + lane;
    f32x4 gg[4], bb[4];
#pragma unroll
    for (int j = 0; j < 4; ++j) { gg[j] = g4[64 * j]; bb[j] = b4[64 * j]; }
    const int gw = vcu * NWAVES + wave, NGW = G * NWAVES;
    for (int m = gw; m < M; m += NGW) {
        int row = 0; if (lane < TOPK) row = off[tope[m * TOPK + lane]] + topp[m * TOPK + lane];
        f32x4 v[4];
#pragma unroll
        for (int j = 0; j < 4; ++j) { const v2u h = *((const v2u*)(h1b + (size_t)m * DM) + lane + 64 * j), s = *((const v2u*)(ysh + (size_t)m * DM) + lane + 64 * j), p = *((const v2u*)(ple + (size_t)m * DM) + lane + 64 * j);
            v[j][0] = ALPHA * pg8::bf_lo(h.x) + pg8::bf_lo(s.x) + pg8::bf_lo(p.x); v[j][1] = ALPHA * pg8::bf_hi(h.x) + pg8::bf_hi(s.x) + pg8::bf_hi(p.x);
            v[j][2] = ALPHA * pg8::bf_lo(h.y) + pg8::bf_lo(s.y) + pg8::bf_lo(p.y); v[j][3] = ALPHA * pg8::bf_hi(h.y) + pg8::bf_hi(s.y) + pg8::bf_hi(p.y); }
#pragma unroll
        for (int k = 0; k < TOPK; ++k) { const int rk = __shfl(row, k); const v2u* yr = (const v2u*)(ys + (size_t)rk * DM) + lane;
#pragma unroll
            for (int j = 0; j < 4; ++j) { const v2u y = yr[64 * j]; v[j][0] += pg8::bf_lo(y.x); v[j][1] += pg8::bf_hi(y.x); v[j][2] += pg8::bf_lo(y.y); v[j][3] += pg8::bf_hi(y.y); } }
        float s = 0.f;
#pragma unroll
        for (int j = 0; j < 4; ++j) s += (v[j][0] + v[j][1]) + (v[j][2] + v[j][3]);
        const float mean = wave_sum(s) * (1.f / DM); float s2 = 0.f;
#pragma unroll
        for (int j = 0; j < 4; ++j) { v[j] = v[j] - mean; s2 += (v[j][0] * v[j][0] + v[j][1] * v[j][1]) + (v[j][2] * v[j][2] + v[j][3] * v[j][3]); }
        const float rstd = 1.f / sqrtf(wave_sum(s2) * (1.f / DM) + LN_EPS);
        f32x4* o = (f32x4*)(a.out + (size_t)m * DM) + lane;
#pragma unroll
        for (int j = 0; j < 4; ++j) o[64 * j] = v[j] * rstd * gg[j] + bb[j];
    }
}

constexpr int MAXT = 6;
constexpr int T_CNT = TAB_OFF, T_OFF = T_CNT + 1024, T_PF = T_OFF + 1040, T_REC = T_PF + 5 * 1040, T_ROWS = T_REC + 4 * MAXT * 4 + 32, T_END = T_ROWS + MAXT * 256 * 4;
static_assert(T_END <= LDS_BYTES && T_ROWS % 16 == 0, "tables fit above the ring");
struct ExpSched1 {
    static constexpr bool PARTIAL = true;
    LAS const int* rec; LAS const int* rows; int nt; const unsigned char* h1b; const unsigned char* we1;
    __device__ bool next(int i, pg8::Unit& u) const { if (i >= 2 * nt) return false; const int k = i >> 1; u.pm = k; u.pn = i & 1; u.aux = rec[2 * MAXT + k]; u.aux2 = rec[3 * MAXT + k]; u.aux3 = rec[k] * M + rec[MAXT + k] * 256; return true; }
    __device__ __forceinline__ const char* a_base(const pg8::Unit&) const { return (const char*)h1b; }
    __device__ __forceinline__ const char* b_base(const pg8::Unit& u) const { return (const char*)we1 + ((size_t)rec[u.pm] * 512 + u.pn * 256) * 1024 * 2; }
    __device__ __forceinline__ unsigned a_off(int pm, int r, int c) const { return ((unsigned)rows[pm * 256 + r] * 1024u + (unsigned)c) * 2u; }
};
struct ExpSched2 {
    static constexpr bool PARTIAL = true;
    LAS const int* rec; int nt; const unsigned char* hexp; const unsigned char* we2;
    __device__ bool next(int i, pg8::Unit& u) const { if (i >= 4 * nt) return false; const int k = i >> 2; u.pm = k; u.pn = i & 3; u.aux = rec[2 * MAXT + k]; u.aux2 = rec[3 * MAXT + k]; u.aux3 = rec[k] * M + rec[MAXT + k] * 256; return true; }
    __device__ __forceinline__ const char* a_base(const pg8::Unit& u) const { return (const char*)hexp + (size_t)u.aux2 * DEXP * 2; }
    __device__ __forceinline__ const char* b_base(const pg8::Unit& u) const { return (const char*)we2 + ((size_t)rec[u.pm] * 1024 + u.pn * 256) * 256 * 2; }
    __device__ __forceinline__ unsigned a_off(int, int, int) const { return 0u; }
};

__global__ void __launch_bounds__(NWAVES * 64, 2) mk_fwd(Args args) {
    extern __shared__ __attribute__((aligned(16))) unsigned char lds_raw[];
    LAS unsigned char* lds = (LAS unsigned char*)lds_raw;
    volatile LAS unsigned* MISC = (volatile LAS unsigned*)(lds + MISC_OFF);
    const int tid = threadIdx.x;
    const int G = gridDim.x; const int bx = blockIdx.x; const int vcu = (G % 8 == 0) ? (bx % 8) * (G / 8) + bx / 8 : bx;
    unsigned char* ws = args.ws;
    gu32* ctl = (gu32*)(ws + WS_CTL);
    for (int u = tid; u < (LDS_BYTES - LDSCTL_OFF) / 4; u += NWAVES * 64) ((LAS unsigned*)(lds + LDSCTL_OFF))[u] = 0u;
    __syncthreads();
    const int lo = args.ph_lo, hi = args.ph_hi;
    const bool one_launch = (hi - lo) > 1;
    XcdBarrier bar; bar.bar = (unsigned*)(ctl + CW_BAR); bar.x = 0; bar.st = nullptr;
    if (one_launch) bar = xcd_barrier_post((unsigned*)(ctl + CW_BAR), MISC + 8);
#ifndef PHASE_MASK
#define PHASE_MASK 0xFFF
#endif
#define IN(k) (((PHASE_MASK >> (k)) & 1) && lo <= (k) && (k) < hi)
#ifndef PHASE_REPEAT
#define PHASE_REPEAT 0
#endif
#ifndef PHASE_REPEAT_FLAGS
#define PHASE_REPEAT_FLAGS 0
#endif
#if MK_N_LAUNCHES == 1
#define REP(k) for (int rep_ = 0; rep_ < (((PHASE_REPEAT >> (k)) & 1) ? 2 : 1); ++rep_)
#else
#define REP(k)
#endif
#define SEAM(k) do { if (IN(k) && IN((k) + 1)) xcd_barrier(bar); } while (0)

    if (IN(0)) REP(0) { phase0(args, lds, vcu, G); } SEAM(0);

    if (IN(1)) REP(1) {
        { pg8::StaticOrder S; S.init((const bf16*)(ws + WS_XB), (const bf16*)(ws + WS_WIN), M, PP, DM, G, bx);
          epi::EpiProj E{(bf16*)(ws + WS_PROJ), (const float*)(ws + WS_CS)};
          pg8::gemm_phase<epi::EpiProj, pg8::StaticOrder, true, true, false>(lds + RING_OFF, DM, S, E); }
        phase_lowrank(args, lds, bx, G);
        { pg8::StaticOrder S; S.init((const bf16*)(ws + WS_PB), (const bf16*)(ws + WS_WP), M, DM, PLE_DIM, G, bx);
          epi::EpiBf16<false> E{(bf16*)(ws + WS_PW), DM};
          pg8::gemm_phase<epi::EpiBf16<false>, pg8::StaticOrder, true, true, false>(lds + RING_OFF, PLE_DIM, S, E); }
    } SEAM(1);

    if (IN(2)) REP(2) { phase_kmean(args, lds, vcu, G); for (int it = vcu; it < BATCH * GLA_H * (SEQ / 64); it += G) gla::prep(args, lds, it); } SEAM(2);

    if (IN(3)) REP(3) {
        const int nmoba = (G == 256) ? 192 : G, moba_id = bx, gla_id = (G == 256) ? bx - 192 : bx, ngla = (G == 256) ? 64 : G;
        if (!(args.flags & 1) && moba_id < nmoba) for (int L = moba_id; L < 192; L += nmoba) {
            const int xcd = L & 7, k = L >> 3, bh = (k / 3) * 8 + xcd, ty = k % 3, b = bh >> 3, h = bh & 7;
            const bf16* proj = (const bf16*)(ws + WS_PROJ) + (size_t)b * SEQ * PP + h * 128; bf16* om = (bf16*)(ws + WS_OM) + (size_t)b * SEQ * DM + h * 128;
            const float* km = (const float*)(ws + WS_KMEAN) + (size_t)bh * MOBA_NB * 128;
            const unsigned blist = (ty == 0) ? 0x37u : ((ty == 1) ? 0x46u : 0x0125u); const int nb = (ty == 2) ? 4 : 2;
            int qb = (int)(blist & 15u);
            moba::BlockRef cur{proj + C_MQ + (size_t)(qb * 256) * PP, proj + C_MK, proj + C_MV, om + (size_t)(qb * 256) * DM, km, qb * 256};
            moba::Seam S;
            moba::prime(cur, (char*)lds_raw, S);
#pragma unroll 1
            for (int i = 0; i < nb; ++i) { const int qn = (i + 1 < nb) ? (int)((blist >> (4 * (i + 1))) & 15u) : qb;
                moba::block(cur, proj + C_MQ + (size_t)(qn * 256) * PP, (char*)lds_raw, S);
                qb = qn; cur.Q = proj + C_MQ + (size_t)(qb * 256) * PP; cur.O = om + (size_t)(qb * 256) * DM; cur.P0 = qb * 256; }
            VM_WAIT(); __syncthreads();
        }
        if (!(args.flags & 2) && gla_id >= 0) for (int L = gla_id; L < 64; L += ngla) {
            const int xcd = L & 7, k = L >> 3, bh = (k >> 1) * 8 + xcd, es = k & 1;
            gla::scan(args, lds, bh >> 2, bh & 3, es);
        }
    } SEAM(3);

    if (IN(4)) REP(4) { phase_glanorm(args, vcu, G); } SEAM(4);

    if (IN(5)) REP(5) {
        { pg8::StaticOrder S; S.init((const bf16*)(ws + WS_A1), (const bf16*)(ws + WS_WGO), M, DM, DM, G, bx);
          epi::EpiGate<false> E{(bf16*)(ws + WS_MERGED), (const bf16*)(ws + WS_PROJ) + C_GA};
          pg8::gemm_phase<epi::EpiGate<false>, pg8::StaticOrder, true, true, false>(lds + RING_OFF, DM, S, E); }
        { pg8::StaticOrder S; S.init((const bf16*)(ws + WS_OM), (const bf16*)(ws + WS_WMO), M, DM, DM, G, bx);
          epi::EpiGate<true> E{(bf16*)(ws + WS_MERGED), (const bf16*)(ws + WS_PROJ) + C_GB};
          pg8::gemm_phase<epi::EpiGate<true>, pg8::StaticOrder, true, true, false>(lds + RING_OFF, DM, S, E); }
    } SEAM(5);

    if (IN(6)) REP(6) {
        pg8::StaticOrder S; S.init((const bf16*)(ws + WS_MERGED), (const bf16*)(ws + WS_WOUT), M, DM, DM, G, bx);
        epi::EpiPre1 E{(const float*)args.in[I_X], (float*)(ws + WS_PRE1)};
        pg8::gemm_phase<epi::EpiPre1, pg8::StaticOrder, true, true, false>(lds + RING_OFF, DM, S, E);
    } SEAM(6);

    if (IN(7)) REP(7) { phase_ln1(args, vcu, G); } SEAM(7);

    if (IN(8)) REP(8) {
        { pg8::StaticOrder S; S.init((const bf16*)(ws + WS_H1B), (const bf16*)(ws + WS_WR), M, NEXP, DM, G, bx);
          epi::EpiF32 E{(float*)(ws + WS_LOGITS), NEXP};
          pg8::gemm_phase<epi::EpiF32, pg8::StaticOrder, true, true, false>(lds + RING_OFF, DM, S, E); }
        { pg8::StaticOrder S; S.init((const bf16*)(ws + WS_H1B), (const bf16*)(ws + WS_WS1), M, 512, DM, G, (bx + 192) % G);
          epi::EpiSwiGLU E{(bf16*)(ws + WS_HSH), nullptr};
          pg8::gemm_phase<epi::EpiSwiGLU, pg8::StaticOrder, true, true, false>(lds + RING_OFF, DM, S, E); }
        { pg8::StaticOrder S; S.init((const bf16*)(ws + WS_H1B), (const bf16*)(ws + WS_WPG), M, DM, DM, G, bx);
          epi::EpiPle E{(const bf16*)(ws + WS_PW), (bf16*)(ws + WS_PLE)};
          pg8::gemm_phase<epi::EpiPle, pg8::StaticOrder, true, true, false>(lds + RING_OFF, DM, S, E); }
    } SEAM(8);

    if (IN(9)) REP(9) { phase_route(args, vcu, G); } SEAM(9);

    if (IN(10)) REP(10) {
        LAS int* cnt = (LAS int*)(lds + T_CNT); LAS int* off = (LAS int*)(lds + T_OFF); LAS int* pf = (LAS int*)(lds + T_PF); LAS int* rec = (LAS int*)(lds + T_REC); LAS int* rows = (LAS int*)(lds + T_ROWS);
        const unsigned* counts = (const unsigned*)(ws + WS_CTL) + CW_COUNTS;
        if (tid < 256) cnt[tid] = (int)counts[tid];
        LDS_WAIT(); __syncthreads();
        if (tid < 6) { int s = 0;
            for (int e = 0; e < 256; ++e) { const int c = cnt[e], rem = c & 255; int v;
                if (tid == 5) { off[e] = s; v = c; }
                else { pf[tid * 260 + e] = s; v = (tid == 0) ? (c >> 8) : ((rem > 0 && ((rem > 192) ? 1 : (rem > 128) ? 2 : (rem > 64) ? 3 : 4) == tid) ? 1 : 0); }
                s += v; }
            if (tid == 5) off[256] = s; else pf[tid * 260 + 256] = s; }
        LDS_WAIT(); __syncthreads();
        int btot[5], nsu = 0;
#pragma unroll
        for (int b = 0; b < 5; ++b) { btot[b] = pf[b * 260 + 256]; nsu += btot[b]; }
        const int nrounds = (nsu + G - 1) / G;
        for (int rb = 0; rb < nrounds; rb += MAXT) {
            int nt = 0;
            for (int k = 0; k < MAXT; ++k) { const int r = rb + k; const int p = r * G + ((r & 1) ? (G - 1 - bx) : bx); if (r < nrounds && p < nsu) nt = k + 1; }
            if (tid < MAXT) { const int r = rb + tid; int p = r * G + ((r & 1) ? (G - 1 - bx) : bx);
                if (r < nrounds && p < nsu) { int b = 0;
#pragma unroll
                    for (int q = 0; q < 4; ++q) { if (b == q && p >= btot[q]) { p -= btot[q]; b = q + 1; } }
                    LAS const int* pb = pf + b * 260; int lo_ = 0, hi_ = 255;
                    while (lo_ < hi_) { const int mid = (lo_ + hi_ + 1) >> 1; if (pb[mid] <= p) lo_ = mid; else hi_ = mid - 1; }
                    const int e = lo_, c = cnt[e], mt = (b == 0) ? (p - pb[e]) : (c >> 8); const int valid = (b == 0) ? 256 : (c & 255);
                    rec[tid] = e; rec[MAXT + tid] = mt; rec[2 * MAXT + tid] = valid; rec[3 * MAXT + tid] = off[e] + mt * 256; }
                else { rec[tid] = 0; rec[MAXT + tid] = 0; rec[2 * MAXT + tid] = 0; rec[3 * MAXT + tid] = 0; } }
            LDS_WAIT(); __syncthreads();
            { const int* list = (const int*)(ws + WS_LIST);
              for (int i = tid; i < nt * 256; i += NWAVES * 64) { const int k = i >> 8, r = i & 255; rows[i] = (r < rec[2 * MAXT + k]) ? list[(size_t)rec[k] * M + rec[MAXT + k] * 256 + r] : 0; } }
            LDS_WAIT(); __syncthreads();
            if (!(args.flags & 4)) { ExpSched1 S{rec, rows, nt, ws + WS_H1B, ws + WS_WE1};
              epi::EpiSwiGLU E{(bf16*)(ws + WS_HEXP), (const float*)(ws + WS_WLIST)};
              pg8::gemm_phase<epi::EpiSwiGLU, ExpSched1, true, true, true>(lds + RING_OFF, DM, S, E); }
            VM_WAIT(); __syncthreads();
            if (!(args.flags & 8)) { ExpSched2 S{rec, nt, ws + WS_HEXP, ws + WS_WE2};
              epi::EpiDown E{(bf16*)(ws + WS_YS)};
              pg8::gemm_phase<epi::EpiDown, ExpSched2, true, true, false>(lds + RING_OFF, DEXP, S, E); }
            __syncthreads();
        }
        if (!(args.flags & 16)) { pg8::StaticOrder S; S.init((const bf16*)(ws + WS_HSH), (const bf16*)(ws + WS_WS2), M, DM, DEXP, G, bx);
          epi::EpiDown E{(bf16*)(ws + WS_YSH)};
          pg8::gemm_phase<epi::EpiDown, pg8::StaticOrder, true, true, false>(lds + RING_OFF, DEXP, S, E); }
    } SEAM(10);

    if (IN(11)) REP(11) { phase_final(args, lds, vcu, G); }
#undef IN
#undef SEAM
}

constexpr int NPHASES = 12;
#ifndef MK_N_LAUNCHES
#define MK_N_LAUNCHES 1
#endif

extern "C" void kernel_launch(void* const* d_in, const int* in_sizes, int n_in, void* d_out, int out_size, void* d_ws, size_t ws_size, hipStream_t stream) {
    static int grid = 0;
    if (grid == 0) {
        if (n_in != 24 || in_sizes[0] != M * DM || out_size != M * DM || ws_size < WS_END) { fprintf(stderr, "kernel_launch: unexpected shapes (n_in %d, in0 %d, out %d, ws %zu < %zu)\n", n_in, n_in > 0 ? in_sizes[0] : -1, out_size, ws_size, (size_t)WS_END); grid = -1; return; }
        int dev = 0, cus = 0;
        if (hipGetDevice(&dev) != hipSuccess || hipDeviceGetAttribute(&cus, hipDeviceAttributeMultiprocessorCount, dev) != hipSuccess) { grid = -1; return; }
        if (hipFuncSetAttribute((const void*)mk_fwd, hipFuncAttributeMaxDynamicSharedMemorySize, LDS_BYTES) != hipSuccess) { fprintf(stderr, "kernel_launch: hipFuncSetAttribute failed\n"); grid = -1; return; }
        int per_cu = 0;
        if (hipOccupancyMaxActiveBlocksPerMultiprocessor(&per_cu, (const void*)mk_fwd, NWAVES * 64, LDS_BYTES) != hipSuccess || per_cu < 1) fprintf(stderr, "kernel_launch: occupancy query reports %d per CU\n", per_cu);
        (void)hipGetLastError();
        grid = cus;
    }
    if (grid < 0) return;
    if (hipMemsetAsync((char*)d_ws + WS_CTL, 0, CTL_ZERO_BYTES, stream) != hipSuccess) { fprintf(stderr, "kernel_launch: memset failed\n"); return; }
    Args a{};
    for (int i = 0; i < 24; ++i) a.in[i] = d_in[i];
    a.out = (float*)d_out; a.ws = (unsigned char*)d_ws;
    if (MK_N_LAUNCHES == 1) { a.ph_lo = 0; a.ph_hi = NPHASES; hipLaunchKernelGGL(mk_fwd, dim3(grid), dim3(NWAVES * 64), LDS_BYTES, stream, a); }
    else { for (int p = 0; p < NPHASES; ++p) { a.ph_lo = p; a.ph_hi = p + 1; for (int r = 0; r < (((PHASE_REPEAT >> p) & 1) ? 2 : 1); ++r) { a.flags = r ? PHASE_REPEAT_FLAGS : 0; hipLaunchKernelGGL(mk_fwd, dim3(grid), dim3(NWAVES * 64), LDS_BYTES, stream, a); } } }
    const hipError_t le = hipPeekAtLastError();
    if (le != hipSuccess) fprintf(stderr, "kernel_launch: launch failed: %s\n", hipGetErrorName(le));
}
```
